# Optimizing an MI355X kernel written in HIP

```python
import math
import jax
import jax.numpy as jnp
from jax import lax
import numpy as np

D_MODEL = 1024
BATCH = 2
SEQ = 8192
DEPTH = 2

GRID_W = 64
CTX_LEN = 256
MIX_WIDTH = D_MODEL
EPS = 1e-6

HY_WIDTH = MIX_WIDTH // 4
HY_ORDER = 2
HY_POS_BANDS = 16
HY_EMB = 2 * HY_POS_BANDS + 1
HY_FILT_HIDDEN = 64
HY_DECAY_TARGET = 1e-2
HY_FAST_DECAY_PCT = 0.3
HY_SLOW_DECAY_PCT = 1.5

SG_HEADS = 4
SG_WIDTH = MIX_WIDTH // 4
SG_HEAD_DIM = SG_WIDTH // SG_HEADS
CHUNK = 128

DA_HEADS = 4
DA_WIDTH = MIX_WIDTH // 2
DA_V_DIM = DA_WIDTH // DA_HEADS
DA_HEAD_DIM = DA_V_DIM // 2
Q_BLOCK = 128
ROPE_BASE = 10000.0

HY_IN = (HY_ORDER + 1) * HY_WIDTH
SG_IN = 2 * SG_WIDTH
DA_IN = 3 * DA_WIDTH
IN_WIDTH = HY_IN + SG_IN + DA_IN
FFN_HIDDEN = (-(-8 * D_MODEL // 3) + 255) // 256 * 256

kernel_name = 'hybrid_hyena_gmlp_diffattn_block'


def rmsnorm(x, g):
    xf = x.astype(jnp.float32)
    y = xf * lax.rsqrt(jnp.mean(xf * xf, axis=-1, keepdims=True) + EPS)
    return (y * g.astype(jnp.float32)).astype(x.dtype)


def grid_positions(rows):
    row = jnp.repeat(jnp.arange(rows, dtype=jnp.int32), GRID_W)
    col = jnp.tile(jnp.arange(GRID_W, dtype=jnp.int32), rows)
    return row, col


def _rope_axis(x, pos):
    half = x.shape[-1] // 2
    inv_freq = ROPE_BASE ** (-jnp.arange(half, dtype=jnp.float32) / half)
    ang = pos.astype(jnp.float32)[:, None] * inv_freq[None, :]
    cos = jnp.cos(ang)[:, None, None, :]
    sin = jnp.sin(ang)[:, None, None, :]
    x1, x2 = x[..., :half], x[..., half:]
    return jnp.concatenate([x1 * cos - x2 * sin, x2 * cos + x1 * sin], axis=-1)


def rope_2d(x, row, col):
    r = x.shape[-1] // 2
    xf = x.astype(jnp.float32)
    out = jnp.concatenate([_rope_axis(xf[..., :r], row), _rope_axis(xf[..., r:], col)], axis=-1)
    return out.astype(x.dtype)


def short_conv3(p, w, b):
    pp = jnp.pad(p, ((0, 0), (1, 1), (0, 0)))
    return pp[:, :-2] * w[0] + pp[:, 1:-1] * w[1] + pp[:, 2:] * w[2] + b


def hyena_filters(L, w1, b1, w2, b2, w3, freq):
    t = jnp.linspace(0.0, 1.0, L, dtype=jnp.float32)[:, None]
    bands = jnp.linspace(1e-4, HY_POS_BANDS - 1, HY_POS_BANDS, dtype=jnp.float32)
    ang = (2.0 * math.pi / L) * jnp.arange(L, dtype=jnp.float32)[:, None] * bands[None, :]
    feats = jnp.concatenate([t, jnp.cos(ang), -jnp.sin(ang)], axis=-1)
    h = jnp.sin(freq[0] * (feats @ w1 + b1))
    h = jnp.sin(freq[1] * (h @ w2 + b2))
    h = (h @ w3).astype(jnp.float32).reshape(L, HY_ORDER, 2, HY_WIDTH)
    min_decay = math.log(HY_DECAY_TARGET) / HY_SLOW_DECAY_PCT
    max_decay = math.log(HY_DECAY_TARGET) / HY_FAST_DECAY_PCT
    deltas = jnp.abs(jnp.linspace(min_decay, max_decay, HY_WIDTH, dtype=jnp.float32))
    h = h * jnp.exp(-t[:, :, None, None] * deltas)
    zero = jnp.zeros((1, HY_ORDER, HY_WIDTH), jnp.float32)
    return jnp.concatenate([h[:, :, 0], zero, h[:0:-1, :, 1]], axis=0)


def fftconv(u, k, bias):
    L = u.shape[1]
    uf = u.astype(jnp.float32)
    spec = jnp.fft.rfft(uf, n=2 * L, axis=1) * jnp.fft.rfft(k, n=2 * L, axis=0)[None]
    y = jnp.fft.irfft(spec, n=2 * L, axis=1)[:, :L]
    return (y + uf * bias.astype(jnp.float32)).astype(u.dtype)


def hyena(p, conv_w, conv_b, w1, b1, w2, b2, w3, freq, bias):
    L = p.shape[1]
    x1, x2, v = jnp.split(short_conv3(p, conv_w, conv_b), 3, axis=-1)
    k = hyena_filters(L, w1, b1, w2, b2, w3, freq)
    z = x1 * fftconv(v, k[:, 0], bias[0])
    return x2 * fftconv(z, k[:, 1], bias[1])


def sgu(p, norm_g, w_s, b_s):
    B, L, _ = p.shape
    u, v = jnp.split(jax.nn.gelu(p, approximate=False), 2, axis=-1)
    v = rmsnorm(v, norm_g).reshape(B, L // CHUNK, CHUNK, SG_HEADS, SG_HEAD_DIM)
    mixed = jnp.einsum('hpq,bnqhd->bnphd', w_s, v) + b_s.T[None, None, :, :, None]
    return u * mixed.reshape(B, L, SG_WIDTH)


def qk_heads(p, g):
    B, L, _ = p.shape
    return rmsnorm(p.reshape(B, L, DA_HEADS, 2, DA_HEAD_DIM), g)


def v_heads(p):
    B, L, _ = p.shape
    return p.reshape(B, L, DA_HEADS, DA_V_DIM)


def diff_attn_block(q, k, v, lam):
    s = jnp.einsum('bqhcd,bkhcd->bhcqk', q, k).astype(jnp.float32) * (DA_HEAD_DIM ** -0.5)
    a = jax.nn.softmax(s, axis=-1)
    w = a[:, :, 0] - lam * a[:, :, 1]
    return jnp.einsum('bhqk,bkhd->bqhd', w.astype(v.dtype), v)


def diff_attention(q, k, v, lam, subln_g, lam_init):
    B, Lq = q.shape[:2]
    qb = q.reshape(B, Lq // Q_BLOCK, Q_BLOCK, DA_HEADS, 2, DA_HEAD_DIM).swapaxes(0, 1)
    o = lax.map(lambda qq: diff_attn_block(qq, k, v, lam), qb)
    o = o.swapaxes(0, 1).reshape(B, Lq, DA_HEADS, DA_V_DIM)
    o = rmsnorm(o, subln_g) * (1.0 - lam_init)
    return o.reshape(B, Lq, DA_WIDTH)


def mix_out(p, att, hy_params, sg_params, w_out):
    hy = hyena(p[..., :HY_IN], *hy_params)
    sg = sgu(p[..., HY_IN:HY_IN + SG_IN], *sg_params)
    return jnp.concatenate([hy, sg, att], axis=-1) @ w_out


def swiglu(h, w1, w2):
    g, u = jnp.split(h @ w1, 2, axis=-1)
    return (jax.nn.silu(g) * u) @ w2


def adaln(cvec, w, b):
    return jnp.split(jax.nn.silu(cvec) @ w + b, 6, axis=-1)


def setup_inputs(seed: int = 0) -> dict:
    key = jax.random.key(seed)
    ks = iter(jax.random.split(key, 32))

    def nrm(shape, scale):
        return jax.random.normal(next(ks), shape, jnp.float32) * scale

    return {
        'x': nrm((BATCH, SEQ, D_MODEL), 1.0),
        'c': nrm((BATCH, D_MODEL), 1.0),
        'ctx': nrm((BATCH, CTX_LEN, D_MODEL), 1.0),
        'c_ctx': nrm((D_MODEL,), 1.0),
        'norm1_g': 1.0 + nrm((DEPTH, D_MODEL), 0.02),
        'norm2_g': 1.0 + nrm((DEPTH, D_MODEL), 0.02),
        'ada_w': nrm((DEPTH, D_MODEL, 6 * D_MODEL), 0.01),
        'ada_b': nrm((DEPTH, 6 * D_MODEL), 0.01),
        'w_in': nrm((DEPTH, D_MODEL, IN_WIDTH), D_MODEL ** -0.5),
        'hy_conv_w': nrm((DEPTH, 3, HY_IN), 3 ** -0.5),
        'hy_conv_b': nrm((DEPTH, HY_IN), 0.01),
        'hy_w1': nrm((DEPTH, HY_EMB, HY_FILT_HIDDEN), HY_EMB ** -0.5),
        'hy_b1': nrm((DEPTH, HY_FILT_HIDDEN), 0.1),
        'hy_w2': nrm((DEPTH, HY_FILT_HIDDEN, HY_FILT_HIDDEN), HY_FILT_HIDDEN ** -0.5),
        'hy_b2': nrm((DEPTH, HY_FILT_HIDDEN), 0.1),
        'hy_w3': nrm((DEPTH, HY_FILT_HIDDEN, HY_ORDER * 2 * HY_WIDTH), 0.02 * HY_FILT_HIDDEN ** -0.5),
        'hy_freq': 1.0 + nrm((DEPTH, 2, HY_FILT_HIDDEN), 0.02),
        'hy_bias': nrm((DEPTH, HY_ORDER, HY_WIDTH), 1.0),
        'sg_norm_g': 1.0 + nrm((DEPTH, SG_WIDTH), 0.02),
        'sg_w': nrm((DEPTH, SG_HEADS, CHUNK, CHUNK), CHUNK ** -0.5),
        'sg_b': 1.0 + nrm((DEPTH, SG_HEADS, CHUNK), 0.1),
        'qn_g': 1.0 + nrm((DEPTH, DA_HEAD_DIM), 0.02),
        'kn_g': 1.0 + nrm((DEPTH, DA_HEAD_DIM), 0.02),
        'lam_p': nrm((DEPTH, 4, DA_HEAD_DIM), 0.1),
        'subln_g': 1.0 + nrm((DEPTH, DA_V_DIM), 0.02),
        'w_out': nrm((DEPTH, MIX_WIDTH, D_MODEL), MIX_WIDTH ** -0.5),
        'ffn_w1': nrm((DEPTH, D_MODEL, 2 * FFN_HIDDEN), D_MODEL ** -0.5),
        'ffn_w2': nrm((DEPTH, FFN_HIDDEN, D_MODEL), FFN_HIDDEN ** -0.5),
    }


def reference(x, c, ctx, c_ctx, norm1_g, norm2_g, ada_w, ada_b, w_in, hy_conv_w, hy_conv_b,
              hy_w1, hy_b1, hy_w2, hy_b2, hy_w3, hy_freq, hy_bias, sg_norm_g, sg_w, sg_b,
              qn_g, kn_g, lam_p, subln_g, w_out, ffn_w1, ffn_w2):
    rows = x.shape[1] // GRID_W
    row, col = grid_positions(rows)
    da_off = HY_IN + SG_IN
    for i in range(DEPTH):
        last = i == DEPTH - 1
        lam_init = 0.8 - 0.6 * math.exp(-0.3 * i)
        sh1_l, sc1_l, g1_l, sh2_l, sc2_l, g2_l = [m[:, None, :] for m in adaln(c, ada_w[i], ada_b[i])]
        sh1_c, sc1_c, g1_c, sh2_c, sc2_c, g2_c = adaln(c_ctx, ada_w[i], ada_b[i])
        hy_params = (hy_conv_w[i], hy_conv_b[i], hy_w1[i], hy_b1[i], hy_w2[i], hy_b2[i],
                     hy_w3[i], hy_freq[i], hy_bias[i])
        sg_params = (sg_norm_g[i], sg_w[i], sg_b[i])
        lp = lam_p[i].astype(jnp.float32)
        lam = jnp.exp(jnp.dot(lp[0], lp[1])) - jnp.exp(jnp.dot(lp[2], lp[3])) + lam_init

        h_l = rmsnorm(x, norm1_g[i]) * (1.0 + sc1_l) + sh1_l
        h_c = rmsnorm(ctx, norm1_g[i]) * (1.0 + sc1_c) + sh1_c
        p_l = h_l @ w_in[i]
        p_c = h_c @ w_in[i]
        a_l = p_l[..., da_off:]
        a_c = p_c[..., da_off:]
        q_l = rope_2d(qk_heads(a_l[..., :DA_WIDTH], qn_g[i]), row, col)
        k_l = rope_2d(qk_heads(a_l[..., DA_WIDTH:2 * DA_WIDTH], kn_g[i]), row, col)
        v_l = v_heads(a_l[..., 2 * DA_WIDTH:])
        k_c = qk_heads(a_c[..., DA_WIDTH:2 * DA_WIDTH], kn_g[i])
        v_c = v_heads(a_c[..., 2 * DA_WIDTH:])
        k_all = jnp.concatenate([k_c, k_l], axis=1)
        v_all = jnp.concatenate([v_c, v_l], axis=1)
        att_l = diff_attention(q_l, k_all, v_all, lam, subln_g[i], lam_init)
        x = x + g1_l * mix_out(p_l, att_l, hy_params, sg_params, w_out[i])
        x = x + g2_l * swiglu(rmsnorm(x, norm2_g[i]) * (1.0 + sc2_l) + sh2_l, ffn_w1[i], ffn_w2[i])

        if not last:
            q_c = qk_heads(a_c[..., :DA_WIDTH], qn_g[i])
            att_c = diff_attention(q_c, k_c, v_c, lam, subln_g[i], lam_init)
            ctx = ctx + g1_c * mix_out(p_c, att_c, hy_params, sg_params, w_out[i])
            ctx = ctx + g2_c * swiglu(rmsnorm(ctx, norm2_g[i]) * (1.0 + sc2_c) + sh2_c, ffn_w1[i], ffn_w2[i])
    return x
```

```cpp
#include <hip/hip_runtime.h>
#include <hip/hip_cooperative_groups.h>
#include <cstdio>
#include <cstdint>
namespace cg = cooperative_groups;

#define LAS __attribute__((address_space(3)))
typedef unsigned short bf16_t;
typedef short bf16x8 __attribute__((ext_vector_type(8)));
typedef float f32x2 __attribute__((ext_vector_type(2)));
typedef float f32x4 __attribute__((ext_vector_type(4)));
typedef float f32x16 __attribute__((ext_vector_type(16)));
typedef unsigned u32x2 __attribute__((ext_vector_type(2)));
typedef unsigned u32x4 __attribute__((ext_vector_type(4)));
typedef __bf16 bf16x2_t __attribute__((ext_vector_type(2)));

constexpr int DM = 1024, NB = 2, SEQ = 8192, CTXL = 256, DEPTH = 2;
constexpr int MLAT = NB * SEQ;
constexpr int MROWS = MLAT + NB * CTXL;
constexpr int INW = 2816, FFH = 2816;
constexpr float EPS = 1e-6f;
constexpr int NTHREADS = 512;

constexpr size_t MiB = 1u << 20;
constexpr size_t WS_MOD = 0;
constexpr size_t WS_ROPE = 256 * 1024;
constexpr size_t WS_CONST = 512 * 1024;
constexpr size_t WS_CTL = 768 * 1024, CTL_BYTES = 16384;
constexpr size_t WS_WIN = 1 * MiB;
constexpr size_t WS_WOUT = 13 * MiB;
constexpr size_t WS_W1 = 17 * MiB;
constexpr size_t WS_W2 = 39 * MiB;
constexpr size_t WS_FILT = 50 * MiB;
constexpr size_t WS_FILTC = 82 * MiB;
constexpr size_t WS_XC = 83 * MiB;
constexpr size_t WS_H = 85 * MiB;
constexpr size_t WS_MIX = 118 * MiB;
constexpr size_t WS_P = 151 * MiB;
constexpr size_t SZ_PHT = (size_t)768 * MROWS * 2;
constexpr size_t SZ_T512 = (size_t)512 * MROWS * 2;
constexpr size_t WS_PHT = WS_P, WS_SG = WS_PHT + SZ_PHT, WS_Q = WS_SG + SZ_T512, WS_K = WS_Q + SZ_T512, WS_VT = WS_K + SZ_T512;
constexpr size_t WS_ACT = WS_P;
constexpr size_t WS_END = WS_P + (size_t)MROWS * FFH * 2;
static_assert(WS_VT + SZ_T512 == WS_END, "alias map");
static_assert(WS_END <= 256 * MiB, "ws");

constexpr int LDS_BYTES = 147456;

__device__ __forceinline__ unsigned pk2(float lo, float hi) { f32x2 v = {lo, hi}; bf16x2_t b = __builtin_convertvector(v, bf16x2_t); return __builtin_bit_cast(unsigned, b); }
__device__ __forceinline__ float bf_lo(unsigned w) { return __uint_as_float(w << 16); }
__device__ __forceinline__ float bf_hi(unsigned w) { return __uint_as_float(w & 0xffff0000u); }
__device__ __forceinline__ float bf2f(bf16_t x) { return __uint_as_float((unsigned)x << 16); }
__device__ __forceinline__ bf16_t f2bf(float f) { return (bf16_t)(pk2(f, 0.f) & 0xffffu); }
__device__ __forceinline__ float shx(float v, int lane, int o) { return __int_as_float(__builtin_amdgcn_ds_bpermute((lane ^ o) << 2, __float_as_int(v))); }
__device__ __forceinline__ float wave_sum(float v, int lane) {
#pragma unroll
    for (int o = 1; o < 64; o <<= 1) v += shx(v, lane, o);
    return v;
}
__device__ __forceinline__ float silu_f(float x) { return x * __builtin_amdgcn_rcpf(1.f + __builtin_amdgcn_exp2f(-1.4426950408889634f * x)); }
__device__ __forceinline__ f32x2 gelu_pk(f32x2 v) {
    const f32x2 av = __builtin_elementwise_abs(v), d = av * 0.2316418882f + 1.0f;
    f32x2 t; t.x = __builtin_amdgcn_rcpf(d.x); t.y = __builtin_amdgcn_rcpf(d.y);
    f32x2 q = t * 0.5307027145f + (-0.7265760135f); q = q * t + 0.7107068705f; q = q * t + (-0.142248368f); q = q * t + 0.127414796f; q = q * t;
    const f32x2 s = (v * v) * (-0.72134752044f);
    f32x2 e; e.x = __builtin_amdgcn_exp2f(s.x); e.y = __builtin_amdgcn_exp2f(s.y);
    const f32x2 m = v * (q * e), r = v - m;
    f32x2 o; o.x = v.x < 0.f ? m.x : r.x; o.y = v.y < 0.f ? m.y : r.y; return o;
}

__device__ __forceinline__ int phys_lin(int c) { const int wc = c >> 6, fq = (c >> 4) & 3, bj = (c >> 3) & 1, n = (c >> 2) & 1, j = c & 3; return 128 * bj + 32 * wc + 16 * n + 4 * fq + j; }
__device__ __forceinline__ int phys_qk(int c) { const int wc = c >> 6, bj = (c >> 5) & 1, n = (c >> 4) & 1, fq = (c >> 2) & 3, j = c & 3; return 128 * bj + 32 * wc + 16 * n + 4 * fq + j; }
__device__ __forceinline__ int phys_row(int mode, int n) {
    if (mode == 0) return n;
    if (mode == 1) { const int t = n >> 8, c = n & 255; if (t < 3 || t >= 9) return n; if (t < 5) return t * 256 + phys_lin(c); return t * 256 + phys_qk(c); }
    const int isU = n >= FFH ? 1 : 0; const int hh = isU ? n - FFH : n;
    const int pn = hh >> 7, wc = (hh >> 5) & 3, fq = (hh >> 3) & 3, bj = (hh >> 2) & 1, j = hh & 3;
    return 256 * pn + 128 * bj + 32 * wc + 16 * isU + 4 * fq + j;
}

namespace pg8 {
constexpr int BM = 256, BK = 64, HALF = 128, HTB = HALF * BK * 2, STAGE_BYTES = 8 * HTB, NXCD = 8, WGM = 8;
__device__ __forceinline__ int lds_byte(int r, int c) { const int st = (r >> 4) * 2 + (c >> 5), rr = r & 15, cc = c & 31, ob = rr * 64 + cc * 2; return st * 1024 + (ob ^ (((ob >> 9) & 1) << 5)); }
__device__ __forceinline__ void stage_rc(int b, int& R, int& C) { const int st = b / 1024, sb = b % 1024, swz = sb ^ (((sb >> 9) & 1) << 5); R = (st >> 1) * 16 + swz / 64; C = (st & 1) * 32 + (swz % 64) / 2; }
struct Unit { int pm, pn, kind; };
__device__ __forceinline__ void tile_order(int L, int nM, int nN, int& pm, int& pn) {
    const int nwg = nM * nN; int wgid = L; { const int q = nwg / NXCD, r = nwg % NXCD, xcd = wgid % NXCD, off = wgid / NXCD; wgid = (xcd < r ? xcd * (q + 1) : r * (q + 1) + (xcd - r) * q) + off; }
    const int nig = WGM * nN, gid = wgid / nig, fm = gid * WGM, gsz = (nM - fm) < WGM ? (nM - fm) : WGM;
    pm = fm + ((wgid % nig) % gsz); pn = (wgid % nig) / gsz;
}
struct SchedPlain {
    const bf16_t* A; const bf16_t* Bt; int nM, nN, G, c, K;
    __device__ __forceinline__ bool next(int i, Unit& u) const { const long L = (long)i * G + c; if (L >= (long)nM * nN) return false; tile_order((int)L, nM, nN, u.pm, u.pn); u.kind = 0; return true; }
    __device__ __forceinline__ const char* pA(const Unit& u) const { return (const char*)A + (size_t)u.pm * 256 * K * 2; }
    __device__ __forceinline__ const char* pB(const Unit& u) const { return (const char*)Bt + (size_t)u.pn * 256 * K * 2; }
};
struct SchedG1 {
    const bf16_t* H; const bf16_t* W; int G, c;
    __device__ __forceinline__ bool next(int i, Unit& u) const {
        const int L = i * G + c; if (L >= 726) return false;
        if (L < 396) { tile_order(L, 66, 6, u.pm, u.pn); u.pn += 3; u.kind = 0; }
        else { const int l2 = L - 396; const int wi = l2 % 5; u.pm = wi < 3 ? wi : wi + 6; u.pn = l2 / 5; u.kind = 1; }
        return true;
    }
    __device__ __forceinline__ const char* pA(const Unit& u) const { return (const char*)(u.kind ? W : H) + (size_t)u.pm * 256 * 1024 * 2; }
    __device__ __forceinline__ const char* pB(const Unit& u) const { return (const char*)(u.kind ? H : W) + (size_t)u.pn * 256 * 1024 * 2; }
};

template <class Epi, class Sched>
__device__ __forceinline__ void gemm_phase(LAS unsigned char* lds, const int K, const Sched& S, const Epi& E) {
    int tid = threadIdx.x; asm volatile("" : "+v"(tid));
    const int wid = __builtin_amdgcn_readfirstlane(tid >> 6), lane = tid & 63, wr = wid >> 2, wc = wid & 3, fr = lane & 15, fq = lane >> 4;
    const int nt = K / BK;
    unsigned voff[2];
#pragma unroll
    for (int i = 0; i < 2; ++i) { int R, C; stage_rc(tid * 16 + i * 8192, R, C); voff[i] = (unsigned)(R * K + C) * 2u; }
    const size_t kstep = (size_t)(BK * 2);
    const size_t hstep = (size_t)HALF * K * 2;
    const unsigned ldsw = (unsigned)wid * 1024u;
    const int aoff = lds_byte(wr * 64 + fr, fq * 8), boff = lds_byte(wc * 32 + fr, fq * 8);
#define PG8_SA(b, h) (((b) * 2 + (h)) * HTB)
#define PG8_SB(b, h) ((4 + (b) * 2 + (h)) * HTB)
#define PG8_STAGE(bufoff, gbase) do { _Pragma("unroll") for (int _i = 0; _i < 2; ++_i) \
        __builtin_amdgcn_global_load_lds((const unsigned*)((const char*)(gbase) + voff[_i]), (LAS unsigned*)(lds + (bufoff) + ldsw + _i * 8192), 16, 0, 0); } while (0)
#define PG8_LDA(dst, b, h) do { _Pragma("unroll") for (int m = 0; m < 4; ++m) _Pragma("unroll") for (int k = 0; k < 2; ++k) dst[m][k] = *(const LAS bf16x8*)(lds + PG8_SA(b, h) + aoff + m * 2048 + k * 1024); } while (0)
#define PG8_LDB(dst, b, h) do { _Pragma("unroll") for (int n = 0; n < 2; ++n) _Pragma("unroll") for (int k = 0; k < 2; ++k) dst[n][k] = *(const LAS bf16x8*)(lds + PG8_SB(b, h) + boff + n * 2048 + k * 1024); } while (0)
#define PG8_MMA(ai, bj, At, Bt) do { __builtin_amdgcn_s_setprio(1); _Pragma("unroll") for (int m = 0; m < 4; ++m) _Pragma("unroll") for (int n = 0; n < 2; ++n) _Pragma("unroll") for (int k = 0; k < 2; ++k) \
        acc[ai][bj][m][n] = __builtin_amdgcn_mfma_f32_16x16x32_bf16(Bt[n][k], At[m][k], acc[ai][bj][m][n], 0, 0, 0); __builtin_amdgcn_s_setprio(0); } while (0)
#define PG8_WAIT_V(n) asm volatile("s_waitcnt vmcnt(" #n ")" ::: "memory")
#define PG8_WAIT_L(n) asm volatile("s_waitcnt lgkmcnt(" #n ")" ::: "memory")
#define PG8_BAR __builtin_amdgcn_s_barrier()
#define PG8_SCHED __builtin_amdgcn_sched_barrier(0)
    Unit cur, nxt; int ui = 0;
    if (!S.next(0, cur)) return;
    f32x4 acc[2][2][4][2];
#pragma unroll
    for (int a = 0; a < 2; ++a)
#pragma unroll
        for (int b = 0; b < 2; ++b)
#pragma unroll
            for (int m = 0; m < 4; ++m)
#pragma unroll
                for (int n = 0; n < 2; ++n) acc[a][b][m][n] = (f32x4){0.f, 0.f, 0.f, 0.f};
    bf16x8 At[4][2], B0[2][2], B1[2][2];
    const char* cA = S.pA(cur); const char* cB = S.pB(cur);
    PG8_STAGE(PG8_SB(0, 0), cB); PG8_STAGE(PG8_SB(0, 1), cB + hstep); PG8_STAGE(PG8_SA(0, 0), cA); PG8_STAGE(PG8_SA(0, 1), cA + hstep);
    if (wr == 1) PG8_BAR;
    PG8_WAIT_V(2); PG8_BAR;
    PG8_STAGE(PG8_SB(1, 0), cB + kstep); PG8_STAGE(PG8_SA(1, 0), cA + kstep); PG8_STAGE(PG8_SB(1, 1), cB + hstep + kstep);
    PG8_WAIT_V(6); PG8_BAR;
    for (;;) {
        const bool has_next = S.next(ui + 1, nxt);
        const char* nA = has_next ? S.pA(nxt) : cA; const char* nB = has_next ? S.pB(nxt) : cB;
        for (int t = 0; t < nt; t += 2) {
            const bool last = (t == nt - 2);
            const char* a1 = cA + (size_t)(t + 1) * kstep;
            const char* a2 = last ? nA : cA + (size_t)(t + 2) * kstep; const char* b2 = last ? nB : cB + (size_t)(t + 2) * kstep;
            const char* a3 = a2 + kstep; const char* b3 = b2 + kstep;
            PG8_LDB(B0, 0, 0); PG8_LDB(B1, 0, 1); PG8_SCHED; PG8_LDA(At, 0, 0); PG8_STAGE(PG8_SA(1, 1), a1 + hstep);
            PG8_WAIT_V(8); PG8_WAIT_L(0); PG8_BAR; PG8_MMA(0, 0, At, B0); PG8_MMA(0, 1, At, B1); PG8_BAR; PG8_SCHED;
            PG8_LDA(At, 0, 1); PG8_STAGE(PG8_SB(0, 0), b2); PG8_STAGE(PG8_SB(0, 1), b2 + hstep); PG8_STAGE(PG8_SA(0, 0), a2);
            PG8_WAIT_V(8); PG8_WAIT_L(0); PG8_BAR; PG8_MMA(1, 0, At, B0); PG8_MMA(1, 1, At, B1); PG8_BAR; PG8_SCHED;
            PG8_LDB(B0, 1, 0); PG8_LDB(B1, 1, 1); PG8_SCHED; PG8_LDA(At, 1, 0); PG8_STAGE(PG8_SA(0, 1), a2 + hstep);
            PG8_WAIT_V(8); PG8_WAIT_L(0); PG8_BAR; PG8_MMA(0, 0, At, B0); PG8_MMA(0, 1, At, B1); PG8_BAR; PG8_SCHED;
            PG8_LDA(At, 1, 1); PG8_STAGE(PG8_SB(1, 0), b3); PG8_STAGE(PG8_SB(1, 1), b3 + hstep); PG8_STAGE(PG8_SA(1, 0), a3);
            PG8_WAIT_V(8); PG8_WAIT_L(0); PG8_BAR; PG8_MMA(1, 0, At, B0); PG8_MMA(1, 1, At, B1); PG8_BAR; PG8_SCHED;
        }
        if (wr == 0) PG8_BAR;
        E(acc, cur, wr, wc, fr, fq);
        if (!has_next) break;
#pragma unroll
        for (int a = 0; a < 2; ++a)
#pragma unroll
            for (int b = 0; b < 2; ++b)
#pragma unroll
                for (int m = 0; m < 4; ++m)
#pragma unroll
                    for (int n = 0; n < 2; ++n) acc[a][b][m][n] = (f32x4){0.f, 0.f, 0.f, 0.f};
        cur = nxt; cA = nA; cB = nB; ++ui;
        if (wr == 1) PG8_BAR;
    }
    PG8_WAIT_V(0);
    PG8_BAR;
#undef PG8_SA
#undef PG8_SB
#undef PG8_STAGE
#undef PG8_LDA
#undef PG8_LDB
#undef PG8_MMA
#undef PG8_WAIT_V
#undef PG8_WAIT_L
#undef PG8_BAR
#undef PG8_SCHED
}

struct EpiG1 {
    bf16_t *PHt, *SG, *Q, *Kb, *VT; const float *qg, *kg; const float* rope; float qscale;
    __device__ __forceinline__ void operator()(const f32x4 (&acc)[2][2][4][2], const Unit& u, int wr, int wc, int fr, int fq) const {
        if (u.kind == 1) {
            bf16_t* base = (u.pm < 3) ? PHt + (size_t)(u.pm * 256) * MROWS : VT + (size_t)((u.pm - 9) * 256) * MROWS;
            const int fqp = (u.pm < 3) ? fq : ((fq == 1) ? 2 : (fq == 2) ? 1 : fq);
#pragma unroll
            for (int ai = 0; ai < 2; ++ai)
#pragma unroll
                for (int m = 0; m < 4; ++m) { bf16_t* rp = base + (size_t)(ai * 128 + wr * 64 + m * 16 + fr) * MROWS + u.pn * 256 + wc * 32 + 4 * fqp;
#pragma unroll
                    for (int bj = 0; bj < 2; ++bj)
#pragma unroll
                        for (int n = 0; n < 2; ++n) { const f32x4 v = acc[ai][bj][m][n]; u32x2 w; w.x = pk2(v[0], v[1]); w.y = pk2(v[2], v[3]); *(u32x2*)(rp + bj * 128 + n * 16) = w; } }
        } else if (u.pn < 5) {
#pragma unroll
            for (int ai = 0; ai < 2; ++ai)
#pragma unroll
                for (int m = 0; m < 4; ++m) { bf16_t* rp = SG + (size_t)(u.pm * 256 + ai * 128 + wr * 64 + m * 16 + fr) * 512 + (u.pn - 3) * 256 + 64 * wc + 16 * fq;
#pragma unroll
                    for (int bj = 0; bj < 2; ++bj) { const f32x4 v0 = acc[ai][bj][m][0], v1 = acc[ai][bj][m][1];
                        const f32x2 a = gelu_pk((f32x2){v0[0], v0[1]}), b = gelu_pk((f32x2){v0[2], v0[3]}), c = gelu_pk((f32x2){v1[0], v1[1]}), d = gelu_pk((f32x2){v1[2], v1[3]});
                        u32x4 w; w.x = pk2(a.x, a.y); w.y = pk2(b.x, b.y); w.z = pk2(c.x, c.y); w.w = pk2(d.x, d.y); *(u32x4*)(rp + 8 * bj) = w; } }
        } else {
            const bool isq = u.pn < 7; const float* g = isq ? qg : kg; bf16_t* out = isq ? Q : Kb; const int tile = u.pn - (isq ? 5 : 7); const float sc = isq ? qscale : 1.f;
            f32x4 gv[2][2];
#pragma unroll
            for (int bj = 0; bj < 2; ++bj)
#pragma unroll
                for (int n = 0; n < 2; ++n) gv[bj][n] = *(const f32x4*)(g + 32 * bj + 16 * n + 4 * fq);
#pragma unroll
            for (int ai = 0; ai < 2; ++ai)
#pragma unroll
                for (int m = 0; m < 4; ++m) {
                    const int row = u.pm * 256 + ai * 128 + wr * 64 + m * 16 + fr;
                    float ss = 0.f;
#pragma unroll
                    for (int bj = 0; bj < 2; ++bj)
#pragma unroll
                        for (int n = 0; n < 2; ++n) { const f32x4 v = acc[ai][bj][m][n]; ss += (v[0] * v[0] + v[1] * v[1]) + (v[2] * v[2] + v[3] * v[3]); }
                    ss += shx(ss, fr + 16 * fq, 16); ss += shx(ss, fr + 16 * fq, 32);
                    const float rstd = __builtin_amdgcn_rsqf(ss * (1.f / 64.f) + EPS) * sc;
                    bf16_t* rp = out + (size_t)row * 512 + tile * 256 + 64 * wc + 4 * fq;
#pragma unroll
                    for (int bj = 0; bj < 2; ++bj) {
                        f32x4 y1 = acc[ai][bj][m][0] * gv[bj][0] * rstd, y2 = acc[ai][bj][m][1] * gv[bj][1] * rstd;
                        if (row < MLAT) {
                            const int t = row & (SEQ - 1); const int pos = bj == 0 ? (t >> 6) : (t & 63);
                            const f32x4 cs0 = *(const f32x4*)(rope + (pos * 16 + 4 * fq) * 2), cs1 = *(const f32x4*)(rope + (pos * 16 + 4 * fq) * 2 + 4);
                            const f32x4 cc = {cs0[0], cs0[2], cs1[0], cs1[2]}, sn = {cs0[1], cs0[3], cs1[1], cs1[3]};
                            const f32x4 o1 = y1 * cc - y2 * sn, o2 = y2 * cc + y1 * sn; y1 = o1; y2 = o2;
                        }
                        u32x2 w; w.x = pk2(y1[0], y1[1]); w.y = pk2(y1[2], y1[3]); *(u32x2*)(rp + 32 * bj) = w;
                        w.x = pk2(y2[0], y2[1]); w.y = pk2(y2[2], y2[3]); *(u32x2*)(rp + 32 * bj + 16) = w;
                    }
                }
        }
    }
};
struct EpiRes {
    const float* baseL; const float* baseC; float* outL; float* outC; const float* gate;
    __device__ __forceinline__ void operator()(const f32x4 (&acc)[2][2][4][2], const Unit& u, int wr, int wc, int fr, int fq) const {
        const int row0 = u.pm * 256; const bool lat = row0 < MLAT; const int mv = lat ? (row0 >> 13) : 2;
        const float* bp = lat ? baseL + (size_t)row0 * DM : baseC + (size_t)(row0 - MLAT) * DM; float* op = lat ? outL + (size_t)row0 * DM : outC + (size_t)(row0 - MLAT) * DM;
        const int col0 = u.pn * 256 + wc * 32 + 4 * fq;
        f32x4 gv[2][2];
#pragma unroll
        for (int bj = 0; bj < 2; ++bj)
#pragma unroll
            for (int n = 0; n < 2; ++n) gv[bj][n] = *(const f32x4*)(gate + mv * 6144 + col0 + bj * 128 + n * 16);
#pragma unroll
        for (int ai = 0; ai < 2; ++ai)
#pragma unroll
            for (int m = 0; m < 4; ++m) { const size_t off = (size_t)(ai * 128 + wr * 64 + m * 16 + fr) * DM + col0;
#pragma unroll
                for (int bj = 0; bj < 2; ++bj)
#pragma unroll
                    for (int n = 0; n < 2; ++n) { const f32x4 b = *(const f32x4*)(bp + off + bj * 128 + n * 16); *(f32x4*)(op + off + bj * 128 + n * 16) = b + gv[bj][n] * acc[ai][bj][m][n]; } }
    }
};
struct EpiSwiglu {
    bf16_t* ACT;
    __device__ __forceinline__ void operator()(const f32x4 (&acc)[2][2][4][2], const Unit& u, int wr, int wc, int fr, int fq) const {
#pragma unroll
        for (int ai = 0; ai < 2; ++ai)
#pragma unroll
            for (int m = 0; m < 4; ++m) { bf16_t* rp = ACT + (size_t)(u.pm * 256 + ai * 128 + wr * 64 + m * 16 + fr) * FFH + u.pn * 128 + 32 * wc + 8 * fq;
                float r[8];
#pragma unroll
                for (int bj = 0; bj < 2; ++bj) { const f32x4 g = acc[ai][bj][m][0], uu = acc[ai][bj][m][1];
#pragma unroll
                    for (int j = 0; j < 4; ++j) r[4 * bj + j] = silu_f(g[j]) * uu[j]; }
                u32x4 w; w.x = pk2(r[0], r[1]); w.y = pk2(r[2], r[3]); w.z = pk2(r[4], r[5]); w.w = pk2(r[6], r[7]); *(u32x4*)rp = w; }
    }
};
}

__device__ __forceinline__ void transpose_item(const float* W, int K, int N, bf16_t* WT, int mode, LAS float* scr, int item, int lane) {
    const int nblk = N / 32, kb = item / nblk, nb = item % nblk, k0 = 64 * kb, n0 = 32 * nb;
#pragma unroll 8
    for (int i = 0; i < 32; ++i) { const int kk = 2 * i + (lane >> 5); scr[kk * 33 + (lane & 31)] = W[(size_t)(k0 + kk) * N + n0 + (lane & 31)]; }
    asm volatile("s_waitcnt lgkmcnt(0)" ::: "memory");
    const int c = lane & 7;
#pragma unroll
    for (int j = 0; j < 4; ++j) { const int n = (lane >> 3) + 8 * j; const LAS float* s = scr + (8 * c) * 33 + n;
        u32x4 o; o.x = pk2(s[0 * 33], s[1 * 33]); o.y = pk2(s[2 * 33], s[3 * 33]); o.z = pk2(s[4 * 33], s[5 * 33]); o.w = pk2(s[6 * 33], s[7 * 33]);
        *(u32x4*)(WT + (size_t)phys_row(mode, n0 + n) * K + k0 + 8 * c) = o; }
    asm volatile("s_waitcnt lgkmcnt(0)" ::: "memory");
}

__device__ __forceinline__ void filter_task(int layer, int L, int l0, int q4, const float* w1, const float* b1, const float* w2, const float* b2, const float* w3, const float* freq,
                                            float* TD, float* FILTC, int lane) {
    const int r = lane & 31, hh = lane >> 5; const int l = l0 + r;
    const float tpos = (float)l / (float)(L - 1);
    const float abase = (float)l / (float)L;
    bf16x8 fb[3];
#pragma unroll
    for (int s = 0; s < 3; ++s) { float fv[8];
#pragma unroll
        for (int j = 0; j < 8; ++j) { const int f = 16 * s + 8 * hh + j; float v = 0.f;
            if (f == 0) v = tpos;
            else if (f <= 16) { const float band = 1e-4f + (float)(f - 1) * ((15.f - 1e-4f) / 15.f); v = __builtin_amdgcn_cosf(abase * band); }
            else if (f <= 32) { const float band = 1e-4f + (float)(f - 17) * ((15.f - 1e-4f) / 15.f); v = -__builtin_amdgcn_sinf(abase * band); }
            fv[j] = v; }
        u32x4 w; w.x = pk2(fv[0], fv[1]); w.y = pk2(fv[2], fv[3]); w.z = pk2(fv[4], fv[5]); w.w = pk2(fv[6], fv[7]); fb[s] = __builtin_bit_cast(bf16x8, w); }
    bf16x8 hb1[4];
#pragma unroll
    for (int ut = 0; ut < 2; ++ut) { f32x16 z = {};
#pragma unroll
        for (int s = 0; s < 3; ++s) { float av[8];
#pragma unroll
            for (int j = 0; j < 8; ++j) { const int f = 16 * s + 8 * hh + j; av[j] = f < 33 ? w1[f * 64 + 32 * ut + r] : 0.f; }
            u32x4 w; w.x = pk2(av[0], av[1]); w.y = pk2(av[2], av[3]); w.z = pk2(av[4], av[5]); w.w = pk2(av[6], av[7]);
            z = __builtin_amdgcn_mfma_f32_32x32x16_bf16(__builtin_bit_cast(bf16x8, w), fb[s], z, 0, 0, 0); }
        float hv[16];
#pragma unroll
        for (int e = 0; e < 16; ++e) { const int un = 32 * ut + (e & 3) + 8 * (e >> 2) + 4 * hh; hv[e] = __builtin_amdgcn_sinf(0.15915494309189535f * freq[un] * (z[e] + b1[un])); }
#pragma unroll
        for (int s2 = 0; s2 < 2; ++s2) { u32x4 w; w.x = pk2(hv[8 * s2], hv[8 * s2 + 1]); w.y = pk2(hv[8 * s2 + 2], hv[8 * s2 + 3]); w.z = pk2(hv[8 * s2 + 4], hv[8 * s2 + 5]); w.w = pk2(hv[8 * s2 + 6], hv[8 * s2 + 7]);
            hb1[2 * ut + s2] = __builtin_bit_cast(bf16x8, w); } }
    bf16x8 hb2[4];
#pragma unroll
    for (int ut = 0; ut < 2; ++ut) { f32x16 z = {};
#pragma unroll
        for (int sp = 0; sp < 4; ++sp) { float av[8];
#pragma unroll
            for (int j = 0; j < 8; ++j) { const int k = 16 * sp + 8 * (j >> 2) + 4 * hh + (j & 3); av[j] = w2[k * 64 + 32 * ut + r]; }
            u32x4 w; w.x = pk2(av[0], av[1]); w.y = pk2(av[2], av[3]); w.z = pk2(av[4], av[5]); w.w = pk2(av[6], av[7]);
            z = __builtin_amdgcn_mfma_f32_32x32x16_bf16(__builtin_bit_cast(bf16x8, w), hb1[sp], z, 0, 0, 0); }
        float hv[16];
#pragma unroll
        for (int e = 0; e < 16; ++e) { const int un = 32 * ut + (e & 3) + 8 * (e >> 2) + 4 * hh; hv[e] = __builtin_amdgcn_sinf(0.15915494309189535f * freq[64 + un] * (z[e] + b2[un])); }
#pragma unroll
        for (int s2 = 0; s2 < 2; ++s2) { u32x4 w; w.x = pk2(hv[8 * s2], hv[8 * s2 + 1]); w.y = pk2(hv[8 * s2 + 2], hv[8 * s2 + 3]); w.z = pk2(hv[8 * s2 + 4], hv[8 * s2 + 5]); w.w = pk2(hv[8 * s2 + 6], hv[8 * s2 + 7]);
            hb2[2 * ut + s2] = __builtin_bit_cast(bf16x8, w); } }
    const float dstep = (15.350567286626973f - 3.0701134573253945f) / 255.f;
#pragma nounroll
    for (int rt = 8 * q4; rt < 8 * q4 + 8; ++rt) { f32x16 z = {};
#pragma unroll
        for (int sp = 0; sp < 4; ++sp) { float av[8];
#pragma unroll
            for (int j = 0; j < 8; ++j) { const int k = 16 * sp + 8 * (j >> 2) + 4 * hh + (j & 3); av[j] = w3[k * 1024 + 32 * rt + r]; }
            u32x4 w; w.x = pk2(av[0], av[1]); w.y = pk2(av[2], av[3]); w.z = pk2(av[4], av[5]); w.w = pk2(av[6], av[7]);
            z = __builtin_amdgcn_mfma_f32_32x32x16_bf16(__builtin_bit_cast(bf16x8, w), hb2[sp], z, 0, 0, 0); }
#pragma unroll
        for (int e = 0; e < 16; ++e) { const int n = 32 * rt + (e & 3) + 8 * (e >> 2) + 4 * hh; const int o = n >> 9, dir = (n >> 8) & 1, c = n & 255;
            const float delta = 3.0701134573253945f + (float)c * dstep;
            float v = z[e] * __expf(-tpos * delta);
            if (L == SEQ) { float* dst = TD + ((size_t)(layer * 256 + c) * 2 + o) * 16384;
                if (dir == 0) dst[l] = v; else if (l == 0) dst[8192] = 0.f; else dst[16384 - l] = v;
            } else { float* dst = FILTC + (size_t)(c * 2 + o) * 512;
                if (dir == 0) dst[256 + l] = v; else if (l == 0) dst[0] = 0.f; else dst[256 - l] = v; } }
    }
}

__device__ __forceinline__ void norm_row(const float* xrow, const float* g, const float* sc, const float* sh, bf16_t* orow, int lane) {
    const f32x4* xr = (const f32x4*)xrow + lane;
    f32x4 v[4]; float s = 0.f;
#pragma unroll
    for (int j = 0; j < 4; ++j) { v[j] = xr[64 * j]; s += (v[j][0] * v[j][0] + v[j][1] * v[j][1]) + (v[j][2] * v[j][2] + v[j][3] * v[j][3]); }
    const float rstd = __builtin_amdgcn_rsqf(wave_sum(s, lane) * (1.f / DM) + EPS);
#pragma unroll
    for (int j = 0; j < 4; ++j) { const int c = 4 * (lane + 64 * j);
        const f32x4 gg = *(const f32x4*)(g + c), ss = *(const f32x4*)(sc + c), hh = *(const f32x4*)(sh + c);
        const f32x4 y = v[j] * rstd * gg * (ss + 1.f) + hh;
        u32x2 w; w.x = pk2(y[0], y[1]); w.y = pk2(y[2], y[3]); *(u32x2*)(orow + c) = w; }
}

__device__ __forceinline__ void attn_unit(LAS unsigned char* lds, const bf16_t* Q, const bf16_t* Kb, const bf16_t* VT, bf16_t* MIX, int h, int qrow0, int ctxrow0, int latrow0, int ntiles,
                                          float lam, float mshift, const float* sg, float oscale) {
    int tid = threadIdx.x; asm volatile("" : "+v"(tid));
    const int lane = tid & 63, w = __builtin_amdgcn_readfirstlane(tid >> 6), r = lane & 31, hh = lane >> 5, qt = w & 3, comp = w >> 2;
    bf16x8 qf[4];
    { const bf16_t* qp = Q + (size_t)(qrow0 + 32 * qt + r) * 512 + h * 128 + comp * 64 + 8 * hh;
#pragma unroll
      for (int s = 0; s < 4; ++s) qf[s] = *(const bf16x8*)(qp + 16 * s); }
    f32x16 o[4];
#pragma unroll
    for (int i = 0; i < 4; ++i) o[i] = (f32x16){};
    float lsum = 0.f;
#define AT_KROW(t) ((t) < 4 ? ctxrow0 + 64 * (t) : latrow0 + 64 * ((t) - 4))
    const int pc_ = lane & 7, rw_ = lane >> 3;
    unsigned koff[2], voff2[2];
#pragma unroll
    for (int i = 0; i < 2; ++i) { const int blk = w * 2 + i; const int cmp = blk >> 3, row = 8 * (blk & 7) + rw_; const int c = pc_ ^ ((row >> 1) & 7);
        koff[i] = (unsigned)((row * 512 + h * 128 + cmp * 64 + c * 8) * 2);
        const int dv = 8 * blk + rw_; const int c2 = pc_ ^ ((dv >> 1) & 7);
        voff2[i] = (unsigned)(((h * 128 + dv) * MROWS + c2 * 8) * 2); }
#define AT_DMA(t, b) do { const int kr0_ = AT_KROW(t); _Pragma("unroll") for (int i_ = 0; i_ < 2; ++i_) { \
        __builtin_amdgcn_global_load_lds((const unsigned*)((const char*)Kb + (size_t)kr0_ * 1024 + koff[i_]), (LAS unsigned*)(lds + (b) * 32768 + (w * 2 + i_) * 1024), 16, 0, 0); \
        __builtin_amdgcn_global_load_lds((const unsigned*)((const char*)VT + (size_t)kr0_ * 2 + voff2[i_]), (LAS unsigned*)(lds + (b) * 32768 + 16384 + (w * 2 + i_) * 1024), 16, 0, 0); } } while (0)
    AT_DMA(0, 0);
    asm volatile("s_waitcnt vmcnt(0)" ::: "memory");
    __syncthreads();
    if (ntiles > 1) AT_DMA(1, 1);
    const int sw = (r >> 1) & 7;
    const f32x16 negm = {};
    (void)mshift;
#define AT_STEP(Scur, Snxt, ksl, kkt, vsl, vkt, DOQK) do { \
        bf16x8 kf_[4], vf_[8]; \
        { LAS unsigned char* kb_ = lds + (ksl) * 32768 + comp * 8192 + r * 128 + (kkt) * 4096; \
          LAS unsigned char* vb_ = lds + (vsl) * 32768 + 16384 + r * 128; \
          if (DOQK) { _Pragma("unroll") for (int s_ = 0; s_ < 4; ++s_) kf_[s_] = *(const LAS bf16x8*)(kb_ + (((2 * s_ + hh) ^ sw) << 4)); } \
          _Pragma("unroll") for (int dvt = 0; dvt < 2; ++dvt) _Pragma("unroll") for (int s2 = 0; s2 < 2; ++s2) vf_[2 * dvt + s2] = *(const LAS bf16x8*)(vb_ + dvt * 4096 + (((4 * (vkt) + 2 * s2 + hh) ^ sw) << 4)); } \
        __builtin_amdgcn_sched_barrier(0); \
        float ps_ = 0.f; \
        _Pragma("unroll") for (int e = 0; e < 16; ++e) { Scur[e] = __builtin_amdgcn_exp2f(Scur[e]); ps_ += Scur[e]; } \
        lsum += ps_; \
        u32x4 p0_, p1_; \
        p0_.x = pk2(Scur[0], Scur[1]); p0_.y = pk2(Scur[2], Scur[3]); p0_.z = pk2(Scur[4], Scur[5]); p0_.w = pk2(Scur[6], Scur[7]); \
        p1_.x = pk2(Scur[8], Scur[9]); p1_.y = pk2(Scur[10], Scur[11]); p1_.z = pk2(Scur[12], Scur[13]); p1_.w = pk2(Scur[14], Scur[15]); \
        const bf16x8 pb0_ = __builtin_bit_cast(bf16x8, p0_), pb1_ = __builtin_bit_cast(bf16x8, p1_); \
        __builtin_amdgcn_sched_barrier(0); \
        { LAS unsigned char* vb_ = lds + (vsl) * 32768 + 16384 + r * 128; \
          _Pragma("unroll") for (int dvt = 2; dvt < 4; ++dvt) _Pragma("unroll") for (int s2 = 0; s2 < 2; ++s2) vf_[2 * dvt + s2] = *(const LAS bf16x8*)(vb_ + dvt * 4096 + (((4 * (vkt) + 2 * s2 + hh) ^ sw) << 4)); } \
        if (DOQK) { Snxt = __builtin_amdgcn_mfma_f32_32x32x16_bf16(kf_[0], qf[0], negm, 0, 0, 0); \
            _Pragma("unroll") for (int s_ = 1; s_ < 4; ++s_) Snxt = __builtin_amdgcn_mfma_f32_32x32x16_bf16(kf_[s_], qf[s_], Snxt, 0, 0, 0); } \
        _Pragma("unroll") for (int dvt = 0; dvt < 4; ++dvt) { \
            o[dvt] = __builtin_amdgcn_mfma_f32_32x32x16_bf16(vf_[2 * dvt], pb0_, o[dvt], 0, 0, 0); \
            o[dvt] = __builtin_amdgcn_mfma_f32_32x32x16_bf16(vf_[2 * dvt + 1], pb1_, o[dvt], 0, 0, 0); } \
        __builtin_amdgcn_sched_barrier(0); } while (0)
    f32x16 Sa, Sb;
    { LAS unsigned char* kb_ = lds + comp * 8192 + r * 128;
      Sa = __builtin_amdgcn_mfma_f32_32x32x16_bf16(*(const LAS bf16x8*)(kb_ + (((0 + hh) ^ sw) << 4)), qf[0], negm, 0, 0, 0);
      Sa = __builtin_amdgcn_mfma_f32_32x32x16_bf16(*(const LAS bf16x8*)(kb_ + (((2 + hh) ^ sw) << 4)), qf[1], Sa, 0, 0, 0);
      Sa = __builtin_amdgcn_mfma_f32_32x32x16_bf16(*(const LAS bf16x8*)(kb_ + (((4 + hh) ^ sw) << 4)), qf[2], Sa, 0, 0, 0);
      Sa = __builtin_amdgcn_mfma_f32_32x32x16_bf16(*(const LAS bf16x8*)(kb_ + (((6 + hh) ^ sw) << 4)), qf[3], Sa, 0, 0, 0); }
#define AT_STEPB(Scur, Snxt, ksl, kkt, vsl, vkt, DOQK, DOPV) do { \
        bf16x8 kf_[4], vf_[8]; \
        { LAS unsigned char* kb_ = lds + (ksl) * 32768 + comp * 8192 + r * 128 + (kkt) * 4096; \
          LAS unsigned char* vb_ = lds + (vsl) * 32768 + 16384 + r * 128; \
          if (DOQK) { _Pragma("unroll") for (int s_ = 0; s_ < 4; ++s_) kf_[s_] = *(const LAS bf16x8*)(kb_ + (((2 * s_ + hh) ^ sw) << 4)); } \
          if (DOPV) { _Pragma("unroll") for (int dvt = 0; dvt < 2; ++dvt) _Pragma("unroll") for (int s2 = 0; s2 < 2; ++s2) vf_[2 * dvt + s2] = *(const LAS bf16x8*)(vb_ + dvt * 4096 + (((4 * (vkt) + 2 * s2 + hh) ^ sw) << 4)); } } \
        __builtin_amdgcn_sched_barrier(0); \
        if (DOPV) { LAS unsigned char* vb_ = lds + (vsl) * 32768 + 16384 + r * 128; \
          _Pragma("unroll") for (int dvt = 2; dvt < 4; ++dvt) _Pragma("unroll") for (int s2 = 0; s2 < 2; ++s2) vf_[2 * dvt + s2] = *(const LAS bf16x8*)(vb_ + dvt * 4096 + (((4 * (vkt) + 2 * s2 + hh) ^ sw) << 4)); } \
        if (DOQK) { Snxt = __builtin_amdgcn_mfma_f32_32x32x16_bf16(kf_[0], qf[0], negm, 0, 0, 0); \
            _Pragma("unroll") for (int s_ = 1; s_ < 4; ++s_) Snxt = __builtin_amdgcn_mfma_f32_32x32x16_bf16(kf_[s_], qf[s_], Snxt, 0, 0, 0); } \
        if (DOPV) { _Pragma("unroll") for (int dvt = 0; dvt < 4; ++dvt) { \
            o[dvt] = __builtin_amdgcn_mfma_f32_32x32x16_bf16(vf_[2 * dvt], Pp0, o[dvt], 0, 0, 0); \
            o[dvt] = __builtin_amdgcn_mfma_f32_32x32x16_bf16(vf_[2 * dvt + 1], Pp1, o[dvt], 0, 0, 0); } } \
        __builtin_amdgcn_sched_barrier(0); \
        { float ps_ = 0.f; \
        _Pragma("unroll") for (int e = 0; e < 16; ++e) { Scur[e] = __builtin_amdgcn_exp2f(Scur[e]); ps_ += Scur[e]; } \
        lsum += ps_; \
        u32x4 p0_, p1_; \
        p0_.x = pk2(Scur[0], Scur[1]); p0_.y = pk2(Scur[2], Scur[3]); p0_.z = pk2(Scur[4], Scur[5]); p0_.w = pk2(Scur[6], Scur[7]); \
        p1_.x = pk2(Scur[8], Scur[9]); p1_.y = pk2(Scur[10], Scur[11]); p1_.z = pk2(Scur[12], Scur[13]); p1_.w = pk2(Scur[14], Scur[15]); \
        Pp0 = __builtin_bit_cast(bf16x8, p0_); Pp1 = __builtin_bit_cast(bf16x8, p1_); } \
        __builtin_amdgcn_sched_barrier(0); } while (0)
    int slot = 0;
    if (comp == 0) {
        for (int t = 0; t < ntiles; ++t) {
            const int slot1 = slot == 2 ? 0 : slot + 1, slot2 = slot1 == 2 ? 0 : slot1 + 1;
            AT_STEP(Sa, Sb, slot, 1, slot, 0, true);
            asm volatile("s_waitcnt vmcnt(0)" ::: "memory");
            __syncthreads();
            if (t + 2 < ntiles) AT_DMA(t + 2, slot2);
            if (t + 1 < ntiles) AT_STEP(Sb, Sa, slot1, 0, slot, 1, true); else AT_STEP(Sb, Sa, slot1, 0, slot, 1, false);
            slot = slot1;
        }
    } else {
        int lane_b = lane; asm volatile("" : "+v"(lane_b));
        const int r = lane_b & 31, hh = lane_b >> 5, sw = (r >> 1) & 7;
        bf16x8 Pp0 = {}, Pp1 = {};
        int slotp = 0;
        for (int t = 0; t < ntiles; ++t) {
            const int slot1 = slot == 2 ? 0 : slot + 1, slot2 = slot1 == 2 ? 0 : slot1 + 1;
            if (t > 0) AT_STEPB(Sa, Sb, slot, 1, slotp, 1, true, true); else AT_STEPB(Sa, Sb, slot, 1, slotp, 1, true, false);
            asm volatile("s_waitcnt vmcnt(0)" ::: "memory");
            __syncthreads();
            if (t + 2 < ntiles) AT_DMA(t + 2, slot2);
            if (t + 1 < ntiles) AT_STEPB(Sb, Sa, slot1, 0, slot, 0, true, true); else AT_STEPB(Sb, Sa, slot1, 0, slot, 0, false, true);
            slotp = slot; slot = slot1;
        }
        { LAS unsigned char* vb_ = lds + slotp * 32768 + 16384 + r * 128;
#pragma unroll
          for (int dvt = 0; dvt < 4; ++dvt) {
              o[dvt] = __builtin_amdgcn_mfma_f32_32x32x16_bf16(*(const LAS bf16x8*)(vb_ + dvt * 4096 + (((4 + hh) ^ sw) << 4)), Pp0, o[dvt], 0, 0, 0);
              o[dvt] = __builtin_amdgcn_mfma_f32_32x32x16_bf16(*(const LAS bf16x8*)(vb_ + dvt * 4096 + (((6 + hh) ^ sw) << 4)), Pp1, o[dvt], 0, 0, 0); } }
    }
    __syncthreads();
#undef AT_STEP
#undef AT_STEPB
#undef AT_KROW
#undef AT_DMA
    lsum += shx(lsum, lane, 32);
    const float inv = 1.f / lsum;
    LAS float* X = (LAS float*)lds;
    if (comp == 1) { const float sc = lam * inv;
#pragma unroll
        for (int dvt = 0; dvt < 4; ++dvt)
#pragma unroll
            for (int e = 0; e < 16; ++e) X[((qt * 4 + dvt) * 16 + e) * 64 + lane] = o[dvt][e] * sc; }
    __syncthreads();
    if (comp == 0) {
        float ss = 0.f;
#pragma unroll
        for (int dvt = 0; dvt < 4; ++dvt)
#pragma unroll
            for (int e = 0; e < 16; ++e) { const float v = o[dvt][e] * inv - X[((qt * 4 + dvt) * 16 + e) * 64 + lane]; o[dvt][e] = v; ss += v * v; }
        ss += shx(ss, lane, 32);
        const float rstd = __builtin_amdgcn_rsqf(ss * (1.f / 128.f) + EPS) * oscale;
        LAS unsigned char* stg = lds + 65536 + qt * (32 * 272);
#pragma unroll
        for (int dvt = 0; dvt < 4; ++dvt)
#pragma unroll
            for (int g = 0; g < 4; ++g) { const int dv0 = 32 * dvt + 8 * g + 4 * hh; const f32x4 gg = *(const f32x4*)(sg + dv0);
                u32x2 wv; wv.x = pk2(o[dvt][4 * g] * rstd * gg[0], o[dvt][4 * g + 1] * rstd * gg[1]); wv.y = pk2(o[dvt][4 * g + 2] * rstd * gg[2], o[dvt][4 * g + 3] * rstd * gg[3]);
                *(LAS u32x2*)(stg + r * 272 + dv0 * 2) = wv; }
        asm volatile("s_waitcnt lgkmcnt(0)" ::: "memory");
#pragma unroll
        for (int i = 0; i < 8; ++i) { const int id = lane + 64 * i, row = id >> 4, c = id & 15;
            const u32x4 v = *(const LAS u32x4*)(stg + row * 272 + c * 16);
            *(u32x4*)(MIX + (size_t)(qrow0 + 32 * qt + row) * DM + 512 + h * 128 + c * 8) = v; }
    }
    __syncthreads();
}

__device__ __forceinline__ void conv3x4(const bf16_t* row, int t0, int lo, int hi, float w0, float w1, float w2, float bb, float (&y)[4]) {
    const u32x2 v = *(const u32x2*)(row + t0);
    float p[6]; p[1] = bf_lo(v.x); p[2] = bf_hi(v.x); p[3] = bf_lo(v.y); p[4] = bf_hi(v.y);
    p[0] = (t0 - 1 >= lo) ? bf2f(row[t0 - 1]) : 0.f; p[5] = (t0 + 4 < hi) ? bf2f(row[t0 + 4]) : 0.f;
#pragma unroll
    for (int j = 0; j < 4; ++j) y[j] = w0 * p[j] + w1 * p[j + 1] + w2 * p[j + 2] + bb;
}
__device__ __forceinline__ float conv3x1(const bf16_t* row, int t, int lo, int hi, float w0, float w1, float w2, float bb) {
    const float a = (t - 1 >= lo) ? bf2f(row[t - 1]) : 0.f, b = bf2f(row[t]), c = (t + 1 < hi) ? bf2f(row[t + 1]) : 0.f;
    return w0 * a + w1 * b + w2 * c + bb;
}
typedef _Float16 h16x2 __attribute__((ext_vector_type(2)));
constexpr int FN = 16384;
__device__ __forceinline__ int fpad(int i) { return i + (i >> 4); }
__device__ __forceinline__ f32x2 cmul(f32x2 a, f32x2 w) { return (f32x2){a.x * w.x - a.y * w.y, a.x * w.y + a.y * w.x}; }
template <bool INV> __device__ __forceinline__ void fft4(f32x2& a, f32x2& b, f32x2& c, f32x2& d) {
    const f32x2 s0 = a + c, s1 = a - c, s2 = b + d, s3 = b - d;
    const f32x2 r3 = INV ? (f32x2){-s3.y, s3.x} : (f32x2){s3.y, -s3.x};
    a = s0 + s2; c = s0 - s2; b = s1 + r3; d = s1 - r3;
}
template <bool INV> __device__ __forceinline__ void fft16(f32x2 (&v)[16]) {
#pragma unroll
    for (int n1 = 0; n1 < 4; ++n1) fft4<INV>(v[n1], v[n1 + 4], v[n1 + 8], v[n1 + 12]);
    constexpr float C1 = 0.92387953251128674f, S1 = 0.38268343236508977f, C2 = 0.70710678118654752f;
    constexpr float sg = INV ? 1.f : -1.f;
    v[5] = cmul(v[5], (f32x2){C1, sg * S1}); v[9] = cmul(v[9], (f32x2){C2, sg * C2}); v[13] = cmul(v[13], (f32x2){S1, sg * C1});
    v[6] = cmul(v[6], (f32x2){C2, sg * C2}); v[10] = cmul(v[10], (f32x2){0.f, sg}); v[14] = cmul(v[14], (f32x2){-C2, sg * C2});
    v[7] = cmul(v[7], (f32x2){S1, sg * C1}); v[11] = cmul(v[11], (f32x2){-C2, sg * C2}); v[15] = cmul(v[15], (f32x2){-C1, -sg * S1});
#pragma unroll
    for (int k2 = 0; k2 < 4; ++k2) fft4<INV>(v[4 * k2], v[4 * k2 + 1], v[4 * k2 + 2], v[4 * k2 + 3]);
}
template <bool INV, int P, class LF>
__device__ __forceinline__ void fft_pass16(LAS f32x2* X, int tid, LF load) {
    asm volatile("" : "+v"(tid));
    f32x2 v[2][16];
#pragma unroll
    for (int bi = 0; bi < 2; ++bi) { const int t = tid + 512 * bi;
#pragma unroll
        for (int r = 0; r < 16; ++r) v[bi][r] = load(t, r); }
#pragma unroll
    for (int bi = 0; bi < 2; ++bi) { const int t = tid + 512 * bi;
        if (P > 1) { const int k = t & (P - 1); const float rv_ = (float)k * (1.f / (float)(P * 16)); const float sn = __builtin_amdgcn_sinf(rv_), cs = __builtin_amdgcn_cosf(rv_);
            const f32x2 w1 = {cs, INV ? sn : -sn}; f32x2 w = w1;
#pragma unroll
            for (int r = 1; r < 16; ++r) { v[bi][r] = cmul(v[bi][r], w); if (r < 15) w = cmul(w, w1); } }
        fft16<INV>(v[bi]); }
    __syncthreads();
#pragma unroll
    for (int bi = 0; bi < 2; ++bi) { const int t = tid + 512 * bi; const int k = t & (P - 1); const int j0 = (t - k) * 16 + k;
#pragma unroll
        for (int m = 0; m < 16; ++m) X[fpad(j0 + m * P)] = v[bi][4 * (m & 3) + (m >> 2)]; }
    __syncthreads();
}
template <bool INV, bool TOREG>
__device__ __forceinline__ void fft_pass4(LAS f32x2* X, int tid, f32x2 (&out)[8][2]) {
    asm volatile("" : "+v"(tid));
    f32x2 v[8][4];
#pragma unroll
    for (int i = 0; i < 8; ++i) { const int t = tid + 512 * i;
#pragma unroll
        for (int r = 0; r < 4; ++r) v[i][r] = X[fpad(t + 4096 * r)]; }
#pragma unroll
    for (int i = 0; i < 8; ++i) { const int t = tid + 512 * i; const float rv_ = (float)t * (1.f / 16384.f); const float sn = __builtin_amdgcn_sinf(rv_), cs = __builtin_amdgcn_cosf(rv_);
        const f32x2 w1 = {cs, INV ? sn : -sn}; const f32x2 w2 = cmul(w1, w1), w3 = cmul(w2, w1);
        v[i][1] = cmul(v[i][1], w1); v[i][2] = cmul(v[i][2], w2); v[i][3] = cmul(v[i][3], w3);
        fft4<INV>(v[i][0], v[i][1], v[i][2], v[i][3]); }
    __syncthreads();
    if (TOREG) {
#pragma unroll
        for (int i = 0; i < 8; ++i) { out[i][0] = v[i][0]; out[i][1] = v[i][1]; }
    } else {
#pragma unroll
        for (int i = 0; i < 8; ++i) { const int t = tid + 512 * i;
#pragma unroll
            for (int r = 0; r < 4; ++r) X[fpad(t + 4096 * r)] = v[i][r]; }
        __syncthreads();
    }
}
__device__ __forceinline__ f32x2 kf_load(const unsigned* F, int f) {
    const int g = f <= 8192 ? f : FN - f;
    const h16x2 hv = __builtin_bit_cast(h16x2, F[g & 8191]);
    float re = (float)hv.x, im = (float)hv.y;
    if (g == 0) im = 0.f; else if (g == 8192) { re = im; im = 0.f; } else if (f > 8192) im = -im;
    return (f32x2){re, im};
}
__device__ __forceinline__ void filter_fft_unit(LAS f32x2* X, const float* TD0, const float* TD1, unsigned* F0, unsigned* F1) {
    int tid = threadIdx.x; asm volatile("" : "+v"(tid));
    fft_pass16<false, 1>(X, tid, [&](int t, int r) -> f32x2 { const int idx = t + 1024 * r; return (f32x2){TD0[idx], TD1[idx]}; });
    auto ldl = [&](int t, int r) -> f32x2 { return X[fpad(t + 1024 * r)]; };
    fft_pass16<false, 16>(X, tid, ldl); fft_pass16<false, 256>(X, tid, ldl);
    f32x2 dummy[8][2]; fft_pass4<false, false>(X, tid, dummy);
    for (int i = 0; i < 16; ++i) { const int f = tid + 512 * i;
        const f32x2 zf = X[fpad(f)], zn = X[fpad((FN - f) & (FN - 1))];
        h16x2 k0 = {(_Float16)(0.5f * (zf.x + zn.x)), (_Float16)(0.5f * (zf.y - zn.y))}, k1 = {(_Float16)(0.5f * (zf.y + zn.y)), (_Float16)(0.5f * (zn.x - zf.x))};
        if (f == 0) { const f32x2 zh = X[fpad(8192)]; k0 = (h16x2){(_Float16)zf.x, (_Float16)zh.x}; k1 = (h16x2){(_Float16)zf.y, (_Float16)zh.y}; }
        F0[f] = __builtin_bit_cast(unsigned, k0); F1[f] = __builtin_bit_cast(unsigned, k1); }
    __syncthreads();
}
__device__ __forceinline__ void hyena_unit(LAS unsigned char* lds, int layer, int c, const bf16_t* PHt, const unsigned* FH, const float* FILTC, const float* cw, const float* cb, const float* hbias, bf16_t* MIX, bool do_ctx) {
    int tid = threadIdx.x; asm volatile("" : "+v"(tid));
    LAS f32x2* X = (LAS f32x2*)lds;
    const bf16_t* x1row = PHt + (size_t)c * MROWS; const bf16_t* x2row = PHt + (size_t)(256 + c) * MROWS; const bf16_t* vrow = PHt + (size_t)(512 + c) * MROWS;
    const float w10 = cw[c], w11 = cw[768 + c], w12 = cw[1536 + c], bb1 = cb[c];
    const float w20 = cw[256 + c], w21 = cw[768 + 256 + c], w22 = cw[1536 + 256 + c], bb2 = cb[256 + c];
    const float wv0 = cw[512 + c], wv1 = cw[768 + 512 + c], wv2 = cw[1536 + 512 + c], bbv = cb[512 + c];
    const float bias0 = hbias[c], bias1 = hbias[256 + c];
    const unsigned* F0 = FH + ((size_t)(layer * 256 + c) * 2) * 8192; const unsigned* F1 = F0 + 8192;
    auto ldl = [&](int t, int r) -> f32x2 { return X[fpad(t + 1024 * r)]; };
    auto ldz = [&](int t, int r) -> f32x2 { if (r >= 8) return (f32x2){0.f, 0.f}; return X[fpad(t + 1024 * r)]; };
    const float sc = 1.f / 16384.f;
    f32x2 y[8][2], z[8][2];
    __syncthreads();
#pragma unroll 4
    for (int i = 0; i < 16; ++i) { const int t = tid + 512 * i;
        X[fpad(t)] = (f32x2){conv3x1(vrow, t, 0, SEQ, wv0, wv1, wv2, bbv), conv3x1(vrow, SEQ + t, SEQ, 2 * SEQ, wv0, wv1, wv2, bbv)}; }
    __syncthreads();
    fft_pass16<false, 1>(X, tid, ldz);
    fft_pass16<false, 16>(X, tid, ldl); fft_pass16<false, 256>(X, tid, ldl); fft_pass4<false, false>(X, tid, y);
#pragma unroll 8
    for (int i = 0; i < 32; ++i) { const int f = tid + 512 * i; X[fpad(f)] = cmul(X[fpad(f)], kf_load(F0, f)) * sc; }
    __syncthreads();
    fft_pass16<true, 1>(X, tid, ldl);
    fft_pass16<true, 16>(X, tid, ldl); fft_pass16<true, 256>(X, tid, ldl); fft_pass4<true, true>(X, tid, y);
#pragma unroll
    for (int i = 0; i < 8; ++i)
#pragma unroll
        for (int r = 0; r < 2; ++r) { const int t = tid + 512 * i + 4096 * r;
            const f32x2 vv = {conv3x1(vrow, t, 0, SEQ, wv0, wv1, wv2, bbv), conv3x1(vrow, SEQ + t, SEQ, 2 * SEQ, wv0, wv1, wv2, bbv)};
            const f32x2 x1 = {conv3x1(x1row, t, 0, SEQ, w10, w11, w12, bb1), conv3x1(x1row, SEQ + t, SEQ, 2 * SEQ, w10, w11, w12, bb1)};
            z[i][r] = x1 * (y[i][r] + vv * bias0); X[fpad(t)] = z[i][r]; if (r) asm volatile("" ::: "memory"); }
    __syncthreads();
    fft_pass16<false, 1>(X, tid, ldz);
    fft_pass16<false, 16>(X, tid, ldl); fft_pass16<false, 256>(X, tid, ldl); fft_pass4<false, false>(X, tid, y);
#pragma unroll 8
    for (int i = 0; i < 32; ++i) { const int f = tid + 512 * i; X[fpad(f)] = cmul(X[fpad(f)], kf_load(F1, f)) * sc; }
    __syncthreads();
    fft_pass16<true, 1>(X, tid, ldl);
    fft_pass16<true, 16>(X, tid, ldl); fft_pass16<true, 256>(X, tid, ldl); fft_pass4<true, true>(X, tid, y);
#pragma unroll
    for (int i = 0; i < 8; ++i)
#pragma unroll
        for (int r = 0; r < 2; ++r) { const int t = tid + 512 * i + 4096 * r;
            const f32x2 x2 = {conv3x1(x2row, t, 0, SEQ, w20, w21, w22, bb2), conv3x1(x2row, SEQ + t, SEQ, 2 * SEQ, w20, w21, w22, bb2)};
            const f32x2 o = x2 * (y[i][r] + z[i][r] * bias1);
            MIX[(size_t)t * DM + c] = f2bf(o.x); MIX[(size_t)(SEQ + t) * DM + c] = f2bf(o.y); if ((i & 1) && r) asm volatile("" ::: "memory"); }
    __syncthreads();
    if (do_ctx) {
        LAS float* G = (LAS float*)lds;
        LAS float* U = (LAS float*)(lds + 4096);
        LAS float* Z = (LAS float*)(lds + 6144);
        const float* gc = FILTC + (size_t)c * 1024;
        G[tid] = gc[tid]; G[512 + tid] = gc[512 + tid];
        const int bc = tid >> 8, t = tid & 255; const int lo = MLAT + bc * CTXL, hi = lo + CTXL; const int tk = lo + t;
        const float vv = conv3x1(vrow, tk, lo, hi, wv0, wv1, wv2, bbv);
        U[tid] = vv;
        __syncthreads();
        float a = 0.f;
        for (int s = 0; s < 256; ++s) a += G[256 + t - s] * U[bc * 256 + s];
        const float zz = conv3x1(x1row, tk, lo, hi, w10, w11, w12, bb1) * (a + bias0 * vv);
        Z[tid] = zz;
        __syncthreads();
        float a2 = 0.f;
        for (int s = 0; s < 256; ++s) a2 += G[512 + 256 + t - s] * Z[bc * 256 + s];
        MIX[(size_t)tk * DM + c] = f2bf(conv3x1(x2row, tk, lo, hi, w20, w21, w22, bb2) * (a2 + bias1 * zz));
        __syncthreads();
    }
}

__device__ __forceinline__ void sgu_unit(LAS unsigned char* lds, int ch, const bf16_t* SG, const float* ng, const float* ws, const float* bs, bf16_t* MIX) {
    int tid = threadIdx.x; asm volatile("" : "+v"(tid));
    const int lane = tid & 63, w = __builtin_amdgcn_readfirstlane(tid >> 6), r = lane & 31, hh = lane >> 5;
    const int m0 = ch * 128;
    const f32x4 g4 = *(const f32x4*)(ng + 4 * lane);
    for (int q = 16 * w; q < 16 * w + 16; ++q) {
        const u32x2 v = *(const u32x2*)(SG + (size_t)(m0 + q) * 512 + 256 + 4 * lane);
        const float a = bf_lo(v.x), b = bf_hi(v.x), c = bf_lo(v.y), d = bf_hi(v.y);
        const float rstd = __builtin_amdgcn_rsqf(wave_sum(a * a + b * b + c * c + d * d, lane) * (1.f / 256.f) + EPS);
        LAS bf16_t* vt = (LAS bf16_t*)lds + (4 * lane) * 136 + q;
        vt[0] = f2bf(a * rstd * g4[0]); vt[136] = f2bf(b * rstd * g4[1]); vt[272] = f2bf(c * rstd * g4[2]); vt[408] = f2bf(d * rstd * g4[3]);
    }
    __syncthreads();
    const int head = w >> 1, ctile = w & 1;
    f32x16 acc[4];
#pragma unroll
    for (int i = 0; i < 4; ++i) acc[i] = (f32x16){};
    for (int ks = 0; ks < 8; ++ks) {
        const bf16x8 bfr = *(const LAS bf16x8*)(lds + (size_t)((64 * head + 32 * ctile + r) * 136 + 16 * ks + 8 * hh) * 2);
#pragma unroll
        for (int rt = 0; rt < 4; ++rt) { const float* wp = ws + ((size_t)head * 128 + 32 * rt + r) * 128 + 16 * ks + 8 * hh;
            const f32x4 a0 = *(const f32x4*)wp, a1 = *(const f32x4*)(wp + 4);
            u32x4 aw; aw.x = pk2(a0[0], a0[1]); aw.y = pk2(a0[2], a0[3]); aw.z = pk2(a1[0], a1[1]); aw.w = pk2(a1[2], a1[3]);
            acc[rt] = __builtin_amdgcn_mfma_f32_32x32x16_bf16(__builtin_bit_cast(bf16x8, aw), bfr, acc[rt], 0, 0, 0); }
    }
    const int d = 64 * head + 32 * ctile + r;
#pragma unroll
    for (int rt = 0; rt < 4; ++rt)
#pragma unroll
        for (int e = 0; e < 16; ++e) { const int p = 32 * rt + (e & 3) + 8 * (e >> 2) + 4 * hh;
            const float mixed = acc[rt][e] + bs[head * 128 + p];
            const float u = bf2f(SG[(size_t)(m0 + p) * 512 + d]);
            MIX[(size_t)(m0 + p) * DM + 256 + d] = f2bf(u * mixed); }
    __syncthreads();
}

#define XB_TMO      128
#define XB_XCNT(j)  (256  + 64 * (j))
#define XB_XSUB(j)  (1280 + 64 * (j))
#define XB_XGEN(j)  (2304 + 64 * (j))
#define XB_TOP      3328
#define XB_TOPGEN   3392
#define XCD_BAR_WORDS 3456
#define XB_SPIN_CAP (1u << 18)
__device__ __forceinline__ unsigned xb_ld(unsigned* p)              { return __hip_atomic_load(p, __ATOMIC_RELAXED, __HIP_MEMORY_SCOPE_AGENT); }
__device__ __forceinline__ unsigned xb_add(unsigned* p, unsigned v) { return __hip_atomic_fetch_add(p, v, __ATOMIC_RELAXED, __HIP_MEMORY_SCOPE_AGENT); }
__device__ __forceinline__ unsigned xb_xcc_id() { return (unsigned)__builtin_amdgcn_s_getreg((3 << 11) | 20) & 0xFu; }
#define XB_SPIN(cond, bar) do { unsigned _sp = 0; while (cond) { __builtin_amdgcn_s_sleep(1); \
    if ((++_sp & 255u) == 0u) { if (xb_ld(&(bar)[XB_TMO])) break; if (_sp > XB_SPIN_CAP) { atomicAdd(&(bar)[XB_TMO], 1u); break; } } } } while (0)
struct XcdBarrier { unsigned* bar; unsigned x; volatile LAS unsigned* st; };
__device__ __forceinline__ XcdBarrier xcd_barrier_post(unsigned* bar, volatile LAS unsigned* st) {
    XcdBarrier b; b.bar = bar; b.x = xb_xcc_id(); b.st = st;
    if (threadIdx.x == 0) (void)xb_add(&bar[XB_XCNT(b.x)], 1u);
    return b;
}
__device__ __forceinline__ void xcd_barrier_complete(unsigned* bar, unsigned x, unsigned& nloc, unsigned& nx) {
    const unsigned G = gridDim.x * gridDim.y * gridDim.z;
    unsigned sum, cnt, mine, sp = 0u;
    for (;;) {
        sum = 0u; cnt = 0u; mine = 0u;
#pragma unroll
        for (unsigned j = 0; j < 16; ++j) { const unsigned c = xb_ld(&bar[XB_XCNT(j)]); sum += c; cnt += (c > 0u) ? 1u : 0u; mine = (j == x) ? c : mine; }
        if (sum == G) break;
        __builtin_amdgcn_s_sleep(1);
        if ((++sp & 255u) == 0u) { if (xb_ld(&bar[XB_TMO])) break; if (sp > XB_SPIN_CAP) { atomicAdd(&bar[XB_TMO], 1u); break; } }
    }
    nloc = mine > 0u ? mine : 1u; nx = cnt > 0u ? cnt : 1u;
}
__device__ __forceinline__ void xcd_barrier(const XcdBarrier& b) {
    asm volatile("s_waitcnt vmcnt(0)" ::: "memory");
    __syncthreads();
    if (threadIdx.x == 0) {
        unsigned* bar = b.bar;
        __builtin_amdgcn_s_waitcnt(0);
        unsigned nloc = b.st[0], nx = b.st[1];
        if (nloc == 0u) { xcd_barrier_complete(bar, b.x, nloc, nx); b.st[0] = nloc; b.st[1] = nx; }
        const unsigned old = xb_add(&bar[XB_XSUB(b.x)], 1u);
        const unsigned gen = old / nloc;
        if (old + 1u == (gen + 1u) * nloc) {
            __builtin_amdgcn_fence(__ATOMIC_RELEASE, "agent");
            asm volatile("s_waitcnt vmcnt(0)" ::: "memory");
            const unsigned og = xb_add(&bar[XB_TOP], 1u);
            const unsigned tg = og / nx;
            if (og + 1u == (tg + 1u) * nx) xb_add(&bar[XB_TOPGEN], 1u);
            else XB_SPIN(xb_ld(&bar[XB_TOPGEN]) == tg, bar);
            __builtin_amdgcn_fence(__ATOMIC_ACQUIRE, "agent");
            xb_add(&bar[XB_XGEN(b.x)], 1u);
            asm volatile("s_waitcnt vmcnt(0)" ::: "memory");
        } else {
            XB_SPIN(xb_ld(&bar[XB_XGEN(b.x)]) == gen, bar);
            __builtin_amdgcn_fence(__ATOMIC_ACQUIRE, "agent");
            asm volatile("s_waitcnt vmcnt(0)" ::: "memory");
        }
    }
    __syncthreads();
}

struct Params { const float* in[28]; float* out; unsigned char* ws; int ph_lo, ph_hi; };
enum { I_X = 0, I_C, I_CTX, I_CCTX, I_N1G, I_N2G, I_ADAW, I_ADAB, I_WIN, I_HCW, I_HCB, I_HW1, I_HB1, I_HW2, I_HB2, I_HW3, I_HFREQ, I_HBIAS, I_SGNG, I_SGW, I_SGB, I_QNG, I_KNG, I_LAMP, I_SUBG, I_WOUT, I_FW1, I_FW2 };
constexpr int NPHASE = 2 + 7 * DEPTH;
#ifndef PHMASK
#define PHMASK 0xFFFF
#endif
#define PM(b) if constexpr ((PHMASK >> (b)) & 1)
#ifndef PROBE_DUP
#define PROBE_DUP 0
#endif

__global__ void __launch_bounds__(NTHREADS, 2) fwd_kernel(Params P) {
    extern __shared__ __attribute__((aligned(16))) unsigned char lds_raw[];
    LAS unsigned char* lds = (LAS unsigned char*)lds_raw;
    cg::grid_group grid = cg::this_grid();
    const int G = gridDim.x, bx = blockIdx.x;
    const int vcu = (G % 8 == 0) ? (bx % 8) * (G / 8) + bx / 8 : bx;
    const int NGW = G * 8;
#define MOD ((float*)(KP->ws + WS_MOD))
#define ROPE ((float*)(KP->ws + WS_ROPE))
#define CONSTS ((float*)(KP->ws + WS_CONST))
#define WinT ((bf16_t*)(KP->ws + WS_WIN))
#define WoutT ((bf16_t*)(KP->ws + WS_WOUT))
#define W1T ((bf16_t*)(KP->ws + WS_W1))
#define W2T ((bf16_t*)(KP->ws + WS_W2))
#define FILT ((unsigned*)(KP->ws + WS_FILT))
#define TDF ((float*)(KP->ws + WS_P))
#define FILTC ((float*)(KP->ws + WS_FILTC))
#define XC ((float*)(KP->ws + WS_XC))
#define H ((bf16_t*)(KP->ws + WS_H))
#define MIX ((bf16_t*)(KP->ws + WS_MIX))
#define PHt ((bf16_t*)(KP->ws + WS_PHT))
#define SG ((bf16_t*)(KP->ws + WS_SG))
#define Qb ((bf16_t*)(KP->ws + WS_Q))
#define Kb ((bf16_t*)(KP->ws + WS_K))
#define VT ((bf16_t*)(KP->ws + WS_VT))
#define ACT ((bf16_t*)(KP->ws + WS_ACT))
    const int lo = P.ph_lo, hi = P.ph_hi;
    int ph = 0;
    if (threadIdx.x < 2) ((LAS unsigned*)(lds + LDS_BYTES - 64))[threadIdx.x] = 0u;
    __syncthreads();
    XcdBarrier xbar = xcd_barrier_post((unsigned*)(P.ws + WS_CTL), (volatile LAS unsigned*)(lds + LDS_BYTES - 64));
    if (hi < 0) grid.sync();
#define PH_BEGIN if (ph >= lo && ph < hi) { const __attribute__((address_space(4))) Params* KP = (const __attribute__((address_space(4))) Params*)__builtin_amdgcn_kernarg_segment_ptr(); asm volatile("" : "+s"(KP)); \
    int tid = threadIdx.x; asm volatile("" : "+v"(tid)); const int lane = tid & 63, wave = __builtin_amdgcn_readfirstlane(tid >> 6), gw = vcu * 8 + wave; (void)lane; (void)gw;
#define PH_END if (ph + 1 < hi) xcd_barrier(xbar); } ++ph;

    if (PROBE_DUP & 16) { for (int q_ = 0; q_ < 16; ++q_) xcd_barrier(xbar); }
    PH_BEGIN
    for (int rep_ = 0; rep_ < ((PROBE_DUP & 1) ? 2 : 1); ++rep_)
    {
        PM(0) {
        LAS float* scr = (LAS float*)(lds + wave * 16384);
        constexpr int I_IN = 16 * 88, I_OUT = 16 * 32, I_1 = 16 * 176, I_2 = 44 * 32, I_LAYER = I_IN + I_OUT + I_1 + I_2;
        for (int it = gw; it < 2 * I_LAYER; it += NGW) {
            const int ly = it / I_LAYER; int rr = it % I_LAYER;
            if (rr < I_IN) { transpose_item(KP->in[I_WIN] + (size_t)ly * DM * INW, DM, INW, WinT + (size_t)ly * INW * DM, 1, scr, rr, lane); continue; } rr -= I_IN;
            if (rr < I_OUT) { transpose_item(KP->in[I_WOUT] + (size_t)ly * DM * DM, DM, DM, WoutT + (size_t)ly * DM * DM, 0, scr, rr, lane); continue; } rr -= I_OUT;
            if (rr < I_1) { transpose_item(KP->in[I_FW1] + (size_t)ly * DM * 2 * FFH, DM, 2 * FFH, W1T + (size_t)ly * 2 * FFH * DM, 2, scr, rr, lane); continue; } rr -= I_1;
            transpose_item(KP->in[I_FW2] + (size_t)ly * FFH * DM, FFH, DM, W2T + (size_t)ly * DM * FFH, 0, scr, rr, lane);
        }
        }
        PM(1) for (int it = gw; it < 2 * 1024 + 32; it += NGW) {
            int ly, L, l0, q4;
            if (it < 2048) { ly = it >> 10; L = SEQ; l0 = ((it & 1023) >> 2) * 32; q4 = it & 3; } else { const int k = it - 2048; ly = 0; L = CTXL; l0 = (k >> 2) * 32; q4 = k & 3; }
            int ln = lane; asm volatile("" : "+v"(ln));
            filter_task(ly, L, l0, q4, KP->in[I_HW1] + ly * 33 * 64, KP->in[I_HB1] + ly * 64, KP->in[I_HW2] + ly * 4096, KP->in[I_HB2] + ly * 64, KP->in[I_HW3] + (size_t)ly * 65536, KP->in[I_HFREQ] + ly * 128, TDF, FILTC, ln);
        }
        PM(2) { const int gt = vcu * NTHREADS + tid;
          if (gt < 2048) { const int pos = gt >> 4, i = gt & 15; const float invf = powf(10000.f, -(float)i / 16.f); const float ang = (float)pos * invf; ROPE[2 * gt] = cosf(ang); ROPE[2 * gt + 1] = sinf(ang); }
          if (gt >= 4096 && gt < 4096 + DEPTH) { const int ly = gt - 4096; const float* lp = KP->in[I_LAMP] + ly * 256; float d0 = 0.f, d1 = 0.f;
              for (int k = 0; k < 64; ++k) { d0 += lp[k] * lp[64 + k]; d1 += lp[128 + k] * lp[192 + k]; }
              const float lam_init = 0.8f - 0.6f * expf(-0.3f * (float)ly);
              float mq = 0.f, mk = 0.f; for (int k = 0; k < 64; ++k) { mq = fmaxf(mq, fabsf(KP->in[I_QNG][ly * 64 + k])); mk = fmaxf(mk, fabsf(KP->in[I_KNG][ly * 64 + k])); }
              CONSTS[ly * 4 + 0] = expf(d0) - expf(d1) + lam_init; CONSTS[ly * 4 + 1] = 8.f * mq * mk * 1.4426950408889634f + 0.5f; CONSTS[ly * 4 + 2] = 1.f - lam_init; }
        }
        __syncthreads();
        PM(2) for (int un = vcu; un < 192; un += G) {
            const int ly = un / 96, n0 = (un % 96) * 64;
            LAS float* sv = (LAS float*)lds;
            LAS float* part = (LAS float*)(lds + 16384);
            for (int k = tid; k < 3072; k += NTHREADS) { const int v = k >> 10, kk = k & 1023; const float x = v < 2 ? KP->in[I_C][v * DM + kk] : KP->in[I_CCTX][kk]; sv[k] = silu_f(x); }
            __syncthreads();
            const int cl = tid & 15, kg = tid >> 4;
            f32x4 a0 = {0.f, 0.f, 0.f, 0.f}, a1 = a0, a2 = a0;
            const float* wp = KP->in[I_ADAW] + (size_t)ly * DM * 6144 + n0 + 4 * cl;
            for (int k = kg * 32; k < kg * 32 + 32; ++k) { const f32x4 w4 = *(const f32x4*)(wp + (size_t)k * 6144); a0 += w4 * sv[k]; a1 += w4 * sv[1024 + k]; a2 += w4 * sv[2048 + k]; }
            *(LAS f32x4*)(part + (kg * 3 + 0) * 64 + 4 * cl) = a0; *(LAS f32x4*)(part + (kg * 3 + 1) * 64 + 4 * cl) = a1; *(LAS f32x4*)(part + (kg * 3 + 2) * 64 + 4 * cl) = a2;
            __syncthreads();
            if (tid < 192) { const int v = tid >> 6, col = tid & 63; float s = KP->in[I_ADAB][ly * 6144 + n0 + col];
                for (int k = 0; k < 32; ++k) s += part[(k * 3 + v) * 64 + col];
                MOD[(ly * 3 + v) * 6144 + n0 + col] = s; }
            __syncthreads();
        }
    }
    PH_END

    PH_BEGIN
    for (int rep_ = 0; rep_ < ((PROBE_DUP & 8) ? 2 : 1); ++rep_)
    for (int un = vcu; un < 512; un += G) { const float* td = TDF + (size_t)un * 2 * 16384; unsigned* fo = FILT + (size_t)un * 2 * 8192;
        filter_fft_unit((LAS f32x2*)lds, td, td + 16384, fo, fo + 8192); }
    PH_END

#pragma nounroll
    for (int ly = 0; ly < DEPTH; ++ly) {
        const bool last = ly == DEPTH - 1;
#define modl (MOD + ly * 3 * 6144)
#define xsrcL (ly == 0 ? KP->in[I_X] : (const float*)KP->out)
#define xsrcC (ly == 0 ? KP->in[I_CTX] : (const float*)XC)
        const int MG = last ? MLAT : MROWS;
        PH_BEGIN
        PM(3) for (int m = gw; m < MROWS; m += NGW) { const bool lat = m < MLAT; const int mv = lat ? (m >> 13) : 2;
            norm_row(lat ? xsrcL + (size_t)m * DM : xsrcC + (size_t)(m - MLAT) * DM, KP->in[I_N1G] + ly * DM, modl + mv * 6144 + 1024, modl + mv * 6144, H + (size_t)m * DM, lane); }
        PH_END
        PH_BEGIN
        for (int rep_ = 0; rep_ < ((PROBE_DUP & 64) ? 2 : 1); ++rep_)
        PM(4) { pg8::SchedG1 S{H, WinT + (size_t)ly * INW * DM, G, bx};
          pg8::EpiG1 E{PHt, SG, Qb, Kb, VT, KP->in[I_QNG] + ly * 64, KP->in[I_KNG] + ly * 64, ROPE, 0.125f * 1.4426950408889634f};
          pg8::gemm_phase(lds, DM, S, E); }
        PH_END
        PH_BEGIN
        {
            const float lam = CONSTS[ly * 4 + 0], mshift = CONSTS[ly * 4 + 1], oscale = CONSTS[ly * 4 + 2];
            const float* sgp = KP->in[I_SUBG] + ly * 128;
            for (int rep_ = 0; rep_ < ((PROBE_DUP & 2) ? 2 : 1); ++rep_)
            PM(5) for (int u = vcu; u < 512; u += G) { const int bh = u >> 6, qb = u & 63, b = bh >> 2, h = bh & 3;
                attn_unit(lds, Qb, Kb, VT, MIX, h, b * SEQ + 128 * qb, MLAT + b * CTXL, b * SEQ, 132, lam, mshift, sgp, oscale); }
            PM(5) if (!last) for (int u = vcu; u < 16; u += G) { const int b = u >> 3, h = (u >> 1) & 3, qb = u & 1;
                attn_unit(lds, Qb, Kb, VT, MIX, h, MLAT + b * CTXL + 128 * qb, MLAT + b * CTXL, 0, 4, lam, mshift, sgp, oscale); }
            for (int rep_ = 0; rep_ < ((PROBE_DUP & 4) ? 2 : 1); ++rep_)
            PM(6) for (int c = vcu; c < 256; c += G)
                hyena_unit(lds, ly, c, PHt, FILT, FILTC, KP->in[I_HCW] + ly * 3 * 768, KP->in[I_HCB] + ly * 768, KP->in[I_HBIAS] + ly * 512, MIX, !last);
            const int nch = last ? MLAT / 128 : MROWS / 128;
            for (int rep_ = 0; rep_ < ((PROBE_DUP & 32) ? 2 : 1); ++rep_)
            PM(7) for (int ch = G - 1 - vcu; ch < nch; ch += G)
                sgu_unit(lds, ch, SG, KP->in[I_SGNG] + ly * 256, KP->in[I_SGW] + (size_t)ly * 4 * 128 * 128, KP->in[I_SGB] + ly * 512, MIX);
        }
        PH_END
        PH_BEGIN
        PM(8) { pg8::SchedPlain S{MIX, WoutT + (size_t)ly * DM * DM, MG / 256, 4, G, bx, DM};
          pg8::EpiRes E{xsrcL, xsrcC, KP->out, XC, modl + 2048};
          pg8::gemm_phase(lds, DM, S, E); }
        PH_END
        PH_BEGIN
        PM(9) for (int m = gw; m < MG; m += NGW) { const bool lat = m < MLAT; const int mv = lat ? (m >> 13) : 2;
            norm_row(lat ? KP->out + (size_t)m * DM : XC + (size_t)(m - MLAT) * DM, KP->in[I_N2G] + ly * DM, modl + mv * 6144 + 4096, modl + mv * 6144 + 3072, H + (size_t)m * DM, lane); }
        PH_END
        PH_BEGIN
        PM(10) { pg8::SchedPlain S{H, W1T + (size_t)ly * 2 * FFH * DM, MG / 256, 22, G, bx, DM};
          pg8::EpiSwiglu E{ACT};
          pg8::gemm_phase(lds, DM, S, E); }
        PH_END
        PH_BEGIN
        PM(11) { pg8::SchedPlain S{ACT, W2T + (size_t)ly * DM * FFH, MG / 256, 4, G, bx, FFH};
          pg8::EpiRes E{KP->out, XC, KP->out, XC, modl + 5120};
          pg8::gemm_phase(lds, FFH, S, E); }
        PH_END
    }
#undef PH_BEGIN
#undef PH_END
}

#ifndef MK_N_LAUNCHES
#define MK_N_LAUNCHES 1
#endif
extern "C" void kernel_launch(void* const* d_in, const int* in_sizes, int n_in, void* d_out, int out_size, void* d_ws, size_t ws_size, hipStream_t stream) {
    static int grid = 0;
    if (grid == 0) {
        if (n_in != 28 || out_size != MLAT * DM || ws_size < WS_END) { fprintf(stderr, "kernel_launch: unexpected shapes (n_in %d out %d ws %zu)\n", n_in, out_size, ws_size); grid = -1; return; }
        int dev = 0, cus = 0, per_cu = 0;
        (void)hipGetDevice(&dev); (void)hipDeviceGetAttribute(&cus, hipDeviceAttributeMultiprocessorCount, dev);
        if (hipFuncSetAttribute((const void*)fwd_kernel, hipFuncAttributeMaxDynamicSharedMemorySize, LDS_BYTES) != hipSuccess) { fprintf(stderr, "kernel_launch: hipFuncSetAttribute failed\n"); grid = -1; return; }
        if (hipOccupancyMaxActiveBlocksPerMultiprocessor(&per_cu, (const void*)fwd_kernel, NTHREADS, LDS_BYTES) != hipSuccess || per_cu < 1) { fprintf(stderr, "kernel_launch: occupancy query %d\n", per_cu); per_cu = 1; }
        (void)hipGetLastError();
        grid = cus * 1;
    }
    if (grid < 0) return;
    if (hipMemsetAsync((char*)d_ws + WS_CTL, 0, CTL_BYTES, stream) != hipSuccess) { fprintf(stderr, "kernel_launch: memset failed\n"); return; }
    Params p{};
    for (int i = 0; i < 28; ++i) p.in[i] = (const float*)d_in[i];
    p.out = (float*)d_out; p.ws = (unsigned char*)d_ws;
#if MK_N_LAUNCHES == 1
    p.ph_lo = 0; p.ph_hi = NPHASE;
    void* args[] = {&p};
    hipError_t e = hipLaunchCooperativeKernel((const void*)fwd_kernel, dim3(grid), dim3(NTHREADS), args, LDS_BYTES, stream);
    if (e != hipSuccess) fprintf(stderr, "cooperative launch failed: %s (grid %d)\n", hipGetErrorString(e), grid);
#else
    for (int k = 0; k < NPHASE; ++k) { p.ph_lo = k; p.ph_hi = k + 1; hipLaunchKernelGGL(fwd_kernel, dim3(grid), dim3(NTHREADS), LDS_BYTES, stream, p); }
#endif
}
```

```cpp
#include <hip/hip_runtime.h>
#include <hip/hip_cooperative_groups.h>
#include <cstdio>
#include <cstdint>
namespace cg = cooperative_groups;

#define LAS __attribute__((address_space(3)))
typedef unsigned short bf16_t;
typedef short bf16x8 __attribute__((ext_vector_type(8)));
typedef float f32x2 __attribute__((ext_vector_type(2)));
typedef float f32x4 __attribute__((ext_vector_type(4)));
typedef float f32x16 __attribute__((ext_vector_type(16)));
typedef unsigned u32x2 __attribute__((ext_vector_type(2)));
typedef unsigned u32x4 __attribute__((ext_vector_type(4)));
typedef __bf16 bf16x2_t __attribute__((ext_vector_type(2)));

constexpr int DM = 1024, NB = 2, SEQ = 8192, CTXL = 256, DEPTH = 2;
constexpr int MLAT = NB * SEQ;
constexpr int MROWS = MLAT + NB * CTXL;
constexpr int INW = 2816, FFH = 2816;
constexpr float EPS = 1e-6f;
constexpr int NTHREADS = 512;

constexpr size_t MiB = 1u << 20;
constexpr size_t WS_MOD = 0;
constexpr size_t WS_ROPE = 256 * 1024;
constexpr size_t WS_CONST = 512 * 1024;
constexpr size_t WS_CTL = 768 * 1024, CTL_BYTES = 16384;
constexpr size_t WS_WIN = 1 * MiB;
constexpr size_t WS_WOUT = 13 * MiB;
constexpr size_t WS_W1 = 17 * MiB;
constexpr size_t WS_W2 = 39 * MiB;
constexpr size_t WS_FILT = 50 * MiB;
constexpr size_t WS_FILTC = 82 * MiB;
constexpr size_t WS_XC = 83 * MiB;
constexpr size_t WS_H = 85 * MiB;
constexpr size_t WS_MIX = 118 * MiB;
constexpr size_t WS_P = 151 * MiB;
constexpr size_t SZ_PHT = (size_t)768 * MROWS * 2;
constexpr size_t SZ_T512 = (size_t)512 * MROWS * 2;
constexpr size_t WS_PHT = WS_P, WS_SG = WS_PHT + SZ_PHT, WS_Q = WS_SG + SZ_T512, WS_K = WS_Q + SZ_T512, WS_VT = WS_K + SZ_T512;
constexpr size_t WS_ACT = WS_P;
constexpr size_t WS_END = WS_P + (size_t)MROWS * FFH * 2;
static_assert(WS_VT + SZ_T512 == WS_END, "alias map");
static_assert(WS_END <= 256 * MiB, "ws");

constexpr int LDS_BYTES = 147456;

__device__ __forceinline__ unsigned pk2(float lo, float hi) { f32x2 v = {lo, hi}; bf16x2_t b = __builtin_convertvector(v, bf16x2_t); return __builtin_bit_cast(unsigned, b); }
__device__ __forceinline__ float bf_lo(unsigned w) { return __uint_as_float(w << 16); }
__device__ __forceinline__ float bf_hi(unsigned w) { return __uint_as_float(w & 0xffff0000u); }
__device__ __forceinline__ float bf2f(bf16_t x) { return __uint_as_float((unsigned)x << 16); }
__device__ __forceinline__ bf16_t f2bf(float f) { return (bf16_t)(pk2(f, 0.f) & 0xffffu); }
__device__ __forceinline__ float shx(float v, int lane, int o) { return __int_as_float(__builtin_amdgcn_ds_bpermute((lane ^ o) << 2, __float_as_int(v))); }
__device__ __forceinline__ float wave_sum(float v, int lane) {
#pragma unroll
    for (int o = 1; o < 64; o <<= 1) v += shx(v, lane, o);
    return v;
}
__device__ __forceinline__ float silu_f(float x) { return x * __builtin_amdgcn_rcpf(1.f + __builtin_amdgcn_exp2f(-1.4426950408889634f * x)); }
__device__ __forceinline__ f32x2 gelu_pk(f32x2 v) {
    const f32x2 av = __builtin_elementwise_abs(v), d = av * 0.2316418882f + 1.0f;
    f32x2 t; t.x = __builtin_amdgcn_rcpf(d.x); t.y = __builtin_amdgcn_rcpf(d.y);
    f32x2 q = t * 0.5307027145f + (-0.7265760135f); q = q * t + 0.7107068705f; q = q * t + (-0.142248368f); q = q * t + 0.127414796f; q = q * t;
    const f32x2 s = (v * v) * (-0.72134752044f);
    f32x2 e; e.x = __builtin_amdgcn_exp2f(s.x); e.y = __builtin_amdgcn_exp2f(s.y);
    const f32x2 m = v * (q * e), r = v - m;
    f32x2 o; o.x = v.x < 0.f ? m.x : r.x; o.y = v.y < 0.f ? m.y : r.y; return o;
}

__device__ __forceinline__ int phys_lin(int c) { const int wc = c >> 6, fq = (c >> 4) & 3, bj = (c >> 3) & 1, n = (c >> 2) & 1, j = c & 3; return 128 * bj + 32 * wc + 16 * n + 4 * fq + j; }
__device__ __forceinline__ int phys_qk(int c) { const int wc = c >> 6, bj = (c >> 5) & 1, n = (c >> 4) & 1, fq = (c >> 2) & 3, j = c & 3; return 128 * bj + 32 * wc + 16 * n + 4 * fq + j; }
__device__ __forceinline__ int phys_row(int mode, int n) {
    if (mode == 0) return n;
    if (mode == 1) { const int t = n >> 8, c = n & 255; if (t < 3 || t >= 9) return n; if (t < 5) return t * 256 + phys_lin(c); return t * 256 + phys_qk(c); }
    const int isU = n >= FFH ? 1 : 0; const int hh = isU ? n - FFH : n;
    const int pn = hh >> 7, wc = (hh >> 5) & 3, fq = (hh >> 3) & 3, bj = (hh >> 2) & 1, j = hh & 3;
    return 256 * pn + 128 * bj + 32 * wc + 16 * isU + 4 * fq + j;
}

namespace pg8 {
constexpr int BM = 256, BK = 64, HALF = 128, HTB = HALF * BK * 2, STAGE_BYTES = 8 * HTB, NXCD = 8, WGM = 8;
__device__ __forceinline__ int lds_byte(int r, int c) { const int st = (r >> 4) * 2 + (c >> 5), rr = r & 15, cc = c & 31, ob = rr * 64 + cc * 2; return st * 1024 + (ob ^ (((ob >> 9) & 1) << 5)); }
__device__ __forceinline__ void stage_rc(int b, int& R, int& C) { const int st = b / 1024, sb = b % 1024, swz = sb ^ (((sb >> 9) & 1) << 5); R = (st >> 1) * 16 + swz / 64; C = (st & 1) * 32 + (swz % 64) / 2; }
struct Unit { int pm, pn, kind; };
__device__ __forceinline__ void tile_order(int L, int nM, int nN, int& pm, int& pn) {
    const int nwg = nM * nN; int wgid = L; { const int q = nwg / NXCD, r = nwg % NXCD, xcd = wgid % NXCD, off = wgid / NXCD; wgid = (xcd < r ? xcd * (q + 1) : r * (q + 1) + (xcd - r) * q) + off; }
    const int nig = WGM * nN, gid = wgid / nig, fm = gid * WGM, gsz = (nM - fm) < WGM ? (nM - fm) : WGM;
    pm = fm + ((wgid % nig) % gsz); pn = (wgid % nig) / gsz;
}
struct SchedPlain {
    const bf16_t* A; const bf16_t* Bt; int nM, nN, G, c, K;
    __device__ __forceinline__ bool next(int i, Unit& u) const { const long L = (long)i * G + c; if (L >= (long)nM * nN) return false; tile_order((int)L, nM, nN, u.pm, u.pn); u.kind = 0; return true; }
    __device__ __forceinline__ const char* pA(const Unit& u) const { return (const char*)A + (size_t)u.pm * 256 * K * 2; }
    __device__ __forceinline__ const char* pB(const Unit& u) const { return (const char*)Bt + (size_t)u.pn * 256 * K * 2; }
};
struct SchedG1 {
    const bf16_t* H; const bf16_t* W; int G, c;
    __device__ __forceinline__ bool next(int i, Unit& u) const {
        const int L = i * G + c; if (L >= 726) return false;
        if (L < 396) { tile_order(L, 66, 6, u.pm, u.pn); u.pn += 3; u.kind = 0; }
        else { const int l2 = L - 396; const int wi = l2 % 5; u.pm = wi < 3 ? wi : wi + 6; u.pn = l2 / 5; u.kind = 1; }
        return true;
    }
    __device__ __forceinline__ const char* pA(const Unit& u) const { return (const char*)(u.kind ? W : H) + (size_t)u.pm * 256 * 1024 * 2; }
    __device__ __forceinline__ const char* pB(const Unit& u) const { return (const char*)(u.kind ? H : W) + (size_t)u.pn * 256 * 1024 * 2; }
};

template <class Epi, class Sched>
__device__ __forceinline__ void gemm_phase(LAS unsigned char* lds, const int K, const Sched& S, const Epi& E) {
    int tid = threadIdx.x; asm volatile("" : "+v"(tid));
    const int wid = __builtin_amdgcn_readfirstlane(tid >> 6), lane = tid & 63, wr = wid >> 2, wc = wid & 3, fr = lane & 15, fq = lane >> 4;
    const int nt = K / BK;
    unsigned voff[2];
#pragma unroll
    for (int i = 0; i < 2; ++i) { int R, C; stage_rc(tid * 16 + i * 8192, R, C); voff[i] = (unsigned)(R * K + C) * 2u; }
    const size_t kstep = (size_t)(BK * 2);
    const size_t hstep = (size_t)HALF * K * 2;
    const unsigned ldsw = (unsigned)wid * 1024u;
    const int aoff = lds_byte(wr * 64 + fr, fq * 8), boff = lds_byte(wc * 32 + fr, fq * 8);
#define PG8_SA(b, h) (((b) * 2 + (h)) * HTB)
#define PG8_SB(b, h) ((4 + (b) * 2 + (h)) * HTB)
#define PG8_STAGE(bufoff, gbase) do { _Pragma("unroll") for (int _i = 0; _i < 2; ++_i) \
        __builtin_amdgcn_global_load_lds((const unsigned*)((const char*)(gbase) + voff[_i]), (LAS unsigned*)(lds + (bufoff) + ldsw + _i * 8192), 16, 0, 0); } while (0)
#define PG8_LDA(dst, b, h) do { _Pragma("unroll") for (int m = 0; m < 4; ++m) _Pragma("unroll") for (int k = 0; k < 2; ++k) dst[m][k] = *(const LAS bf16x8*)(lds + PG8_SA(b, h) + aoff + m * 2048 + k * 1024); } while (0)
#define PG8_LDB(dst, b, h) do { _Pragma("unroll") for (int n = 0; n < 2; ++n) _Pragma("unroll") for (int k = 0; k < 2; ++k) dst[n][k] = *(const LAS bf16x8*)(lds + PG8_SB(b, h) + boff + n * 2048 + k * 1024); } while (0)
#define PG8_MMA(ai, bj, At, Bt) do { __builtin_amdgcn_s_setprio(1); _Pragma("unroll") for (int m = 0; m < 4; ++m) _Pragma("unroll") for (int n = 0; n < 2; ++n) _Pragma("unroll") for (int k = 0; k < 2; ++k) \
        acc[ai][bj][m][n] = __builtin_amdgcn_mfma_f32_16x16x32_bf16(Bt[n][k], At[m][k], acc[ai][bj][m][n], 0, 0, 0); __builtin_amdgcn_s_setprio(0); } while (0)
#define PG8_WAIT_V(n) asm volatile("s_waitcnt vmcnt(" #n ")" ::: "memory")
#define PG8_WAIT_L(n) asm volatile("s_waitcnt lgkmcnt(" #n ")" ::: "memory")
#define PG8_BAR __builtin_amdgcn_s_barrier()
#define PG8_SCHED __builtin_amdgcn_sched_barrier(0)
    Unit cur, nxt; int ui = 0;
    if (!S.next(0, cur)) return;
    f32x4 acc[2][2][4][2];
#pragma unroll
    for (int a = 0; a < 2; ++a)
#pragma unroll
        for (int b = 0; b < 2; ++b)
#pragma unroll
            for (int m = 0; m < 4; ++m)
#pragma unroll
                for (int n = 0; n < 2; ++n) acc[a][b][m][n] = (f32x4){0.f, 0.f, 0.f, 0.f};
    bf16x8 At[4][2], B0[2][2], B1[2][2];
    const char* cA = S.pA(cur); const char* cB = S.pB(cur);
    PG8_STAGE(PG8_SB(0, 0), cB); PG8_STAGE(PG8_SB(0, 1), cB + hstep); PG8_STAGE(PG8_SA(0, 0), cA); PG8_STAGE(PG8_SA(0, 1), cA + hstep);
    if (wr == 1) PG8_BAR;
    PG8_WAIT_V(2); PG8_BAR;
    PG8_STAGE(PG8_SB(1, 0), cB + kstep); PG8_STAGE(PG8_SA(1, 0), cA + kstep); PG8_STAGE(PG8_SB(1, 1), cB + hstep + kstep);
    PG8_WAIT_V(6); PG8_BAR;
    for (;;) {
        const bool has_next = S.next(ui + 1, nxt);
        const char* nA = has_next ? S.pA(nxt) : cA; const char* nB = has_next ? S.pB(nxt) : cB;
        for (int t = 0; t < nt; t += 2) {
            const bool last = (t == nt - 2);
            const char* a1 = cA + (size_t)(t + 1) * kstep;
            const char* a2 = last ? nA : cA + (size_t)(t + 2) * kstep; const char* b2 = last ? nB : cB + (size_t)(t + 2) * kstep;
            const char* a3 = a2 + kstep; const char* b3 = b2 + kstep;
            PG8_LDB(B0, 0, 0); PG8_LDB(B1, 0, 1); PG8_SCHED; PG8_LDA(At, 0, 0); PG8_STAGE(PG8_SA(1, 1), a1 + hstep);
            PG8_WAIT_V(8); PG8_WAIT_L(0); PG8_BAR; PG8_MMA(0, 0, At, B0); PG8_MMA(0, 1, At, B1); PG8_BAR; PG8_SCHED;
            PG8_LDA(At, 0, 1); PG8_STAGE(PG8_SB(0, 0), b2); PG8_STAGE(PG8_SB(0, 1), b2 + hstep); PG8_STAGE(PG8_SA(0, 0), a2);
            PG8_WAIT_V(8); PG8_WAIT_L(0); PG8_BAR; PG8_MMA(1, 0, At, B0); PG8_MMA(1, 1, At, B1); PG8_BAR; PG8_SCHED;
            PG8_LDB(B0, 1, 0); PG8_LDB(B1, 1, 1); PG8_SCHED; PG8_LDA(At, 1, 0); PG8_STAGE(PG8_SA(0, 1), a2 + hstep);
            PG8_WAIT_V(8); PG8_WAIT_L(0); PG8_BAR; PG8_MMA(0, 0, At, B0); PG8_MMA(0, 1, At, B1); PG8_BAR; PG8_SCHED;
            PG8_LDA(At, 1, 1); PG8_STAGE(PG8_SB(1, 0), b3); PG8_STAGE(PG8_SB(1, 1), b3 + hstep); PG8_STAGE(PG8_SA(1, 0), a3);
            PG8_WAIT_V(8); PG8_WAIT_L(0); PG8_BAR; PG8_MMA(1, 0, At, B0); PG8_MMA(1, 1, At, B1); PG8_BAR; PG8_SCHED;
        }
        if (wr == 0) PG8_BAR;
        E(acc, cur, wr, wc, fr, fq);
        if (!has_next) break;
#pragma unroll
        for (int a = 0; a < 2; ++a)
#pragma unroll
            for (int b = 0; b < 2; ++b)
#pragma unroll
                for (int m = 0; m < 4; ++m)
#pragma unroll
                    for (int n = 0; n < 2; ++n) acc[a][b][m][n] = (f32x4){0.f, 0.f, 0.f, 0.f};
        cur = nxt; cA = nA; cB = nB; ++ui;
        if (wr == 1) PG8_BAR;
    }
    PG8_WAIT_V(0);
    PG8_BAR;
#undef PG8_SA
#undef PG8_SB
#undef PG8_STAGE
#undef PG8_LDA
#undef PG8_LDB
#undef PG8_MMA
#undef PG8_WAIT_V
#undef PG8_WAIT_L
#undef PG8_BAR
#undef PG8_SCHED
}

struct EpiG1 {
    bf16_t *PHt, *SG, *Q, *Kb, *VT; const float *qg, *kg; const float* rope; float qscale;
    __device__ __forceinline__ void operator()(const f32x4 (&acc)[2][2][4][2], const Unit& u, int wr, int wc, int fr, int fq) const {
        if (u.kind == 1) {
            bf16_t* base = (u.pm < 3) ? PHt + (size_t)(u.pm * 256) * MROWS : VT + (size_t)((u.pm - 9) * 256) * MROWS;
            const int fqp = (u.pm < 3) ? fq : ((fq == 1) ? 2 : (fq == 2) ? 1 : fq);
#pragma unroll
            for (int ai = 0; ai < 2; ++ai)
#pragma unroll
                for (int m = 0; m < 4; ++m) { bf16_t* rp = base + (size_t)(ai * 128 + wr * 64 + m * 16 + fr) * MROWS + u.pn * 256 + wc * 32 + 4 * fqp;
#pragma unroll
                    for (int bj = 0; bj < 2; ++bj)
#pragma unroll
                        for (int n = 0; n < 2; ++n) { const f32x4 v = acc[ai][bj][m][n]; u32x2 w; w.x = pk2(v[0], v[1]); w.y = pk2(v[2], v[3]); *(u32x2*)(rp + bj * 128 + n * 16) = w; } }
        } else if (u.pn < 5) {
#pragma unroll
            for (int ai = 0; ai < 2; ++ai)
#pragma unroll
                for (int m = 0; m < 4; ++m) { bf16_t* rp = SG + (size_t)(u.pm * 256 + ai * 128 + wr * 64 + m * 16 + fr) * 512 + (u.pn - 3) * 256 + 64 * wc + 16 * fq;
#pragma unroll
                    for (int bj = 0; bj < 2; ++bj) { const f32x4 v0 = acc[ai][bj][m][0], v1 = acc[ai][bj][m][1];
                        const f32x2 a = gelu_pk((f32x2){v0[0], v0[1]}), b = gelu_pk((f32x2){v0[2], v0[3]}), c = gelu_pk((f32x2){v1[0], v1[1]}), d = gelu_pk((f32x2){v1[2], v1[3]});
                        u32x4 w; w.x = pk2(a.x, a.y); w.y = pk2(b.x, b.y); w.z = pk2(c.x, c.y); w.w = pk2(d.x, d.y); *(u32x4*)(rp + 8 * bj) = w; } }
        } else {
            const bool isq = u.pn < 7; const float* g = isq ? qg : kg; bf16_t* out = isq ? Q : Kb; const int tile = u.pn - (isq ? 5 : 7); const float sc = isq ? qscale : 1.f;
            f32x4 gv[2][2];
#pragma unroll
            for (int bj = 0; bj < 2; ++bj)
#pragma unroll
                for (int n = 0; n < 2; ++n) gv[bj][n] = *(const f32x4*)(g + 32 * bj + 16 * n + 4 * fq);
#pragma unroll
            for (int ai = 0; ai < 2; ++ai)
#pragma unroll
                for (int m = 0; m < 4; ++m) {
                    const int row = u.pm * 256 + ai * 128 + wr * 64 + m * 16 + fr;
                    float ss = 0.f;
#pragma unroll
                    for (int bj = 0; bj < 2; ++bj)
#pragma unroll
                        for (int n = 0; n < 2; ++n) { const f32x4 v = acc[ai][bj][m][n]; ss += (v[0] * v[0] + v[1] * v[1]) + (v[2] * v[2] + v[3] * v[3]); }
                    ss += shx(ss, fr + 16 * fq, 16); ss += shx(ss, fr + 16 * fq, 32);
                    const float rstd = __builtin_amdgcn_rsqf(ss * (1.f / 64.f) + EPS) * sc;
                    bf16_t* rp = out + (size_t)row * 512 + tile * 256 + 64 * wc + 4 * fq;
#pragma unroll
                    for (int bj = 0; bj < 2; ++bj) {
                        f32x4 y1 = acc[ai][bj][m][0] * gv[bj][0] * rstd, y2 = acc[ai][bj][m][1] * gv[bj][1] * rstd;
                        if (row < MLAT) {
                            const int t = row & (SEQ - 1); const int pos = bj == 0 ? (t >> 6) : (t & 63);
                            const f32x4 cs0 = *(const f32x4*)(rope + (pos * 16 + 4 * fq) * 2), cs1 = *(const f32x4*)(rope + (pos * 16 + 4 * fq) * 2 + 4);
                            const f32x4 cc = {cs0[0], cs0[2], cs1[0], cs1[2]}, sn = {cs0[1], cs0[3], cs1[1], cs1[3]};
                            const f32x4 o1 = y1 * cc - y2 * sn, o2 = y2 * cc + y1 * sn; y1 = o1; y2 = o2;
                        }
                        u32x2 w; w.x = pk2(y1[0], y1[1]); w.y = pk2(y1[2], y1[3]); *(u32x2*)(rp + 32 * bj) = w;
                        w.x = pk2(y2[0], y2[1]); w.y = pk2(y2[2], y2[3]); *(u32x2*)(rp + 32 * bj + 16) = w;
                    }
                }
        }
    }
};
struct EpiRes {
    const float* baseL; const float* baseC; float* outL; float* outC; const float* gate;
    __device__ __forceinline__ void operator()(const f32x4 (&acc)[2][2][4][2], const Unit& u, int wr, int wc, int fr, int fq) const {
        const int row0 = u.pm * 256; const bool lat = row0 < MLAT; const int mv = lat ? (row0 >> 13) : 2;
        const float* bp = lat ? baseL + (size_t)row0 * DM : baseC + (size_t)(row0 - MLAT) * DM; float* op = lat ? outL + (size_t)row0 * DM : outC + (size_t)(row0 - MLAT) * DM;
        const int col0 = u.pn * 256 + wc * 32 + 4 * fq;
        f32x4 gv[2][2];
#pragma unroll
        for (int bj = 0; bj < 2; ++bj)
#pragma unroll
            for (int n = 0; n < 2; ++n) gv[bj][n] = *(const f32x4*)(gate + mv * 6144 + col0 + bj * 128 + n * 16);
#pragma unroll
        for (int ai = 0; ai < 2; ++ai)
#pragma unroll
            for (int m = 0; m < 4; ++m) { const size_t off = (size_t)(ai * 128 + wr * 64 + m * 16 + fr) * DM + col0;
#pragma unroll
                for (int bj = 0; bj < 2; ++bj)
#pragma unroll
                    for (int n = 0; n < 2; ++n) { const f32x4 b = *(const f32x4*)(bp + off + bj * 128 + n * 16); *(f32x4*)(op + off + bj * 128 + n * 16) = b + gv[bj][n] * acc[ai][bj][m][n]; } }
    }
};
struct EpiSwiglu {
    bf16_t* ACT;
    __device__ __forceinline__ void operator()(const f32x4 (&acc)[2][2][4][2], const Unit& u, int wr, int wc, int fr, int fq) const {
#pragma unroll
        for (int ai = 0; ai < 2; ++ai)
#pragma unroll
            for (int m = 0; m < 4; ++m) { bf16_t* rp = ACT + (size_t)(u.pm * 256 + ai * 128 + wr * 64 + m * 16 + fr) * FFH + u.pn * 128 + 32 * wc + 8 * fq;
                float r[8];
#pragma unroll
                for (int bj = 0; bj < 2; ++bj) { const f32x4 g = acc[ai][bj][m][0], uu = acc[ai][bj][m][1];
#pragma unroll
                    for (int j = 0; j < 4; ++j) r[4 * bj + j] = silu_f(g[j]) * uu[j]; }
                u32x4 w; w.x = pk2(r[0], r[1]); w.y = pk2(r[2], r[3]); w.z = pk2(r[4], r[5]); w.w = pk2(r[6], r[7]); *(u32x4*)rp = w; }
    }
};
}

__device__ __forceinline__ void transpose_item(const float* W, int K, int N, bf16_t* WT, int mode, LAS float* scr, int item, int lane) {
    const int nblk = N / 32, kb = item / nblk, nb = item % nblk, k0 = 64 * kb, n0 = 32 * nb;
#pragma unroll 8
    for (int i = 0; i < 32; ++i) { const int kk = 2 * i + (lane >> 5); scr[kk * 33 + (lane & 31)] = W[(size_t)(k0 + kk) * N + n0 + (lane & 31)]; }
    asm volatile("s_waitcnt lgkmcnt(0)" ::: "memory");
    const int c = lane & 7;
#pragma unroll
    for (int j = 0; j < 4; ++j) { const int n = (lane >> 3) + 8 * j; const LAS float* s = scr + (8 * c) * 33 + n;
        u32x4 o; o.x = pk2(s[0 * 33], s[1 * 33]); o.y = pk2(s[2 * 33], s[3 * 33]); o.z = pk2(s[4 * 33], s[5 * 33]); o.w = pk2(s[6 * 33], s[7 * 33]);
        *(u32x4*)(WT + (size_t)phys_row(mode, n0 + n) * K + k0 + 8 * c) = o; }
    asm volatile("s_waitcnt lgkmcnt(0)" ::: "memory");
}

__device__ __forceinline__ void filter_task(int layer, int L, int l0, int q4, const float* w1, const float* b1, const float* w2, const float* b2, const float* w3, const float* freq,
                                            float* TD, float* FILTC, int lane) {
    const int r = lane & 31, hh = lane >> 5; const int l = l0 + r;
    const float tpos = (float)l / (float)(L - 1);
    const float abase = (float)l / (float)L;
    bf16x8 fb[3];
#pragma unroll
    for (int s = 0; s < 3; ++s) { float fv[8];
#pragma unroll
        for (int j = 0; j < 8; ++j) { const int f = 16 * s + 8 * hh + j; float v = 0.f;
            if (f == 0) v = tpos;
            else if (f <= 16) { const float band = 1e-4f + (float)(f - 1) * ((15.f - 1e-4f) / 15.f); v = __builtin_amdgcn_cosf(abase * band); }
            else if (f <= 32) { const float band = 1e-4f + (float)(f - 17) * ((15.f - 1e-4f) / 15.f); v = -__builtin_amdgcn_sinf(abase * band); }
            fv[j] = v; }
        u32x4 w; w.x = pk2(fv[0], fv[1]); w.y = pk2(fv[2], fv[3]); w.z = pk2(fv[4], fv[5]); w.w = pk2(fv[6], fv[7]); fb[s] = __builtin_bit_cast(bf16x8, w); }
    bf16x8 hb1[4];
#pragma unroll
    for (int ut = 0; ut < 2; ++ut) { f32x16 z = {};
#pragma unroll
        for (int s = 0; s < 3; ++s) { float av[8];
#pragma unroll
            for (int j = 0; j < 8; ++j) { const int f = 16 * s + 8 * hh + j; av[j] = f < 33 ? w1[f * 64 + 32 * ut + r] : 0.f; }
            u32x4 w; w.x = pk2(av[0], av[1]); w.y = pk2(av[2], av[3]); w.z = pk2(av[4], av[5]); w.w = pk2(av[6], av[7]);
            z = __builtin_amdgcn_mfma_f32_32x32x16_bf16(__builtin_bit_cast(bf16x8, w), fb[s], z, 0, 0, 0); }
        float hv[16];
#pragma unroll
        for (int e = 0; e < 16; ++e) { const int un = 32 * ut + (e & 3) + 8 * (e >> 2) + 4 * hh; hv[e] = __builtin_amdgcn_sinf(0.15915494309189535f * freq[un] * (z[e] + b1[un])); }
#pragma unroll
        for (int s2 = 0; s2 < 2; ++s2) { u32x4 w; w.x = pk2(hv[8 * s2], hv[8 * s2 + 1]); w.y = pk2(hv[8 * s2 + 2], hv[8 * s2 + 3]); w.z = pk2(hv[8 * s2 + 4], hv[8 * s2 + 5]); w.w = pk2(hv[8 * s2 + 6], hv[8 * s2 + 7]);
            hb1[2 * ut + s2] = __builtin_bit_cast(bf16x8, w); } }
    bf16x8 hb2[4];
#pragma unroll
    for (int ut = 0; ut < 2; ++ut) { f32x16 z = {};
#pragma unroll
        for (int sp = 0; sp < 4; ++sp) { float av[8];
#pragma unroll
            for (int j = 0; j < 8; ++j) { const int k = 16 * sp + 8 * (j >> 2) + 4 * hh + (j & 3); av[j] = w2[k * 64 + 32 * ut + r]; }
            u32x4 w; w.x = pk2(av[0], av[1]); w.y = pk2(av[2], av[3]); w.z = pk2(av[4], av[5]); w.w = pk2(av[6], av[7]);
            z = __builtin_amdgcn_mfma_f32_32x32x16_bf16(__builtin_bit_cast(bf16x8, w), hb1[sp], z, 0, 0, 0); }
        float hv[16];
#pragma unroll
        for (int e = 0; e < 16; ++e) { const int un = 32 * ut + (e & 3) + 8 * (e >> 2) + 4 * hh; hv[e] = __builtin_amdgcn_sinf(0.15915494309189535f * freq[64 + un] * (z[e] + b2[un])); }
#pragma unroll
        for (int s2 = 0; s2 < 2; ++s2) { u32x4 w; w.x = pk2(hv[8 * s2], hv[8 * s2 + 1]); w.y = pk2(hv[8 * s2 + 2], hv[8 * s2 + 3]); w.z = pk2(hv[8 * s2 + 4], hv[8 * s2 + 5]); w.w = pk2(hv[8 * s2 + 6], hv[8 * s2 + 7]);
            hb2[2 * ut + s2] = __builtin_bit_cast(bf16x8, w); } }
    const float dstep = (15.350567286626973f - 3.0701134573253945f) / 255.f;
#pragma nounroll
    for (int rt = 8 * q4; rt < 8 * q4 + 8; ++rt) { f32x16 z = {};
#pragma unroll
        for (int sp = 0; sp < 4; ++sp) { float av[8];
#pragma unroll
            for (int j = 0; j < 8; ++j) { const int k = 16 * sp + 8 * (j >> 2) + 4 * hh + (j & 3); av[j] = w3[k * 1024 + 32 * rt + r]; }
            u32x4 w; w.x = pk2(av[0], av[1]); w.y = pk2(av[2], av[3]); w.z = pk2(av[4], av[5]); w.w = pk2(av[6], av[7]);
            z = __builtin_amdgcn_mfma_f32_32x32x16_bf16(__builtin_bit_cast(bf16x8, w), hb2[sp], z, 0, 0, 0); }
#pragma unroll
        for (int e = 0; e < 16; ++e) { const int n = 32 * rt + (e & 3) + 8 * (e >> 2) + 4 * hh; const int o = n >> 9, dir = (n >> 8) & 1, c = n & 255;
            const float delta = 3.0701134573253945f + (float)c * dstep;
            float v = z[e] * __expf(-tpos * delta);
            if (L == SEQ) { float* dst = TD + ((size_t)(layer * 256 + c) * 2 + o) * 16384;
                if (dir == 0) dst[l] = v; else if (l == 0) dst[8192] = 0.f; else dst[16384 - l] = v;
            } else { float* dst = FILTC + (size_t)(c * 2 + o) * 512;
                if (dir == 0) dst[256 + l] = v; else if (l == 0) dst[0] = 0.f; else dst[256 - l] = v; } }
    }
}

__device__ __forceinline__ void norm_row(const float* xrow, const float* g, const float* sc, const float* sh, bf16_t* orow, int lane) {
    const f32x4* xr = (const f32x4*)xrow + lane;
    f32x4 v[4]; float s = 0.f;
#pragma unroll
    for (int j = 0; j < 4; ++j) { v[j] = xr[64 * j]; s += (v[j][0] * v[j][0] + v[j][1] * v[j][1]) + (v[j][2] * v[j][2] + v[j][3] * v[j][3]); }
    const float rstd = __builtin_amdgcn_rsqf(wave_sum(s, lane) * (1.f / DM) + EPS);
#pragma unroll
    for (int j = 0; j < 4; ++j) { const int c = 4 * (lane + 64 * j);
        const f32x4 gg = *(const f32x4*)(g + c), ss = *(const f32x4*)(sc + c), hh = *(const f32x4*)(sh + c);
        const f32x4 y = v[j] * rstd * gg * (ss + 1.f) + hh;
        u32x2 w; w.x = pk2(y[0], y[1]); w.y = pk2(y[2], y[3]); *(u32x2*)(orow + c) = w; }
}

__device__ __forceinline__ void attn_unit(LAS unsigned char* lds, const bf16_t* Q, const bf16_t* Kb, const bf16_t* VT, bf16_t* MIX, int h, int qrow0, int ctxrow0, int latrow0, int ntiles,
                                          float lam, float mshift, const float* sg, float oscale) {
    int tid = threadIdx.x; asm volatile("" : "+v"(tid));
    const int lane = tid & 63, w = __builtin_amdgcn_readfirstlane(tid >> 6), r = lane & 31, hh = lane >> 5, qt = w & 3, comp = w >> 2;
    bf16x8 qf[4];
    { const bf16_t* qp = Q + (size_t)(qrow0 + 32 * qt + r) * 512 + h * 128 + comp * 64 + 8 * hh;
#pragma unroll
      for (int s = 0; s < 4; ++s) qf[s] = *(const bf16x8*)(qp + 16 * s); }
    f32x16 o[4];
#pragma unroll
    for (int i = 0; i < 4; ++i) o[i] = (f32x16){};
    float lsum = 0.f;
#define AT_KROW(t) ((t) < 4 ? ctxrow0 + 64 * (t) : latrow0 + 64 * ((t) - 4))
    const int pc_ = lane & 7, rw_ = lane >> 3;
    unsigned koff[2], voff2[2];
#pragma unroll
    for (int i = 0; i < 2; ++i) { const int blk = w * 2 + i; const int cmp = blk >> 3, row = 8 * (blk & 7) + rw_; const int c = pc_ ^ ((row >> 1) & 7);
        koff[i] = (unsigned)((row * 512 + h * 128 + cmp * 64 + c * 8) * 2);
        const int dv = 8 * blk + rw_; const int c2 = pc_ ^ ((dv >> 1) & 7);
        voff2[i] = (unsigned)(((h * 128 + dv) * MROWS + c2 * 8) * 2); }
#define AT_DMA(t, b) do { const int kr0_ = AT_KROW(t); _Pragma("unroll") for (int i_ = 0; i_ < 2; ++i_) { \
        __builtin_amdgcn_global_load_lds((const unsigned*)((const char*)Kb + (size_t)kr0_ * 1024 + koff[i_]), (LAS unsigned*)(lds + (b) * 32768 + (w * 2 + i_) * 1024), 16, 0, 0); \
        __builtin_amdgcn_global_load_lds((const unsigned*)((const char*)VT + (size_t)kr0_ * 2 + voff2[i_]), (LAS unsigned*)(lds + (b) * 32768 + 16384 + (w * 2 + i_) * 1024), 16, 0, 0); } } while (0)
    AT_DMA(0, 0);
    asm volatile("s_waitcnt vmcnt(0)" ::: "memory");
    __syncthreads();
    if (ntiles > 1) AT_DMA(1, 1);
    const int sw = (r >> 1) & 7;
    const f32x16 negm = {};
    (void)mshift;
#define AT_STEP(Scur, Snxt, ksl, kkt, vsl, vkt, DOQK) do { \
        bf16x8 kf_[4], vf_[8]; \
        { LAS unsigned char* kb_ = lds + (ksl) * 32768 + comp * 8192 + r * 128 + (kkt) * 4096; \
          LAS unsigned char* vb_ = lds + (vsl) * 32768 + 16384 + r * 128; \
          if (DOQK) { _Pragma("unroll") for (int s_ = 0; s_ < 4; ++s_) kf_[s_] = *(const LAS bf16x8*)(kb_ + (((2 * s_ + hh) ^ sw) << 4)); } \
          _Pragma("unroll") for (int dvt = 0; dvt < 2; ++dvt) _Pragma("unroll") for (int s2 = 0; s2 < 2; ++s2) vf_[2 * dvt + s2] = *(const LAS bf16x8*)(vb_ + dvt * 4096 + (((4 * (vkt) + 2 * s2 + hh) ^ sw) << 4)); } \
        __builtin_amdgcn_sched_barrier(0); \
        float ps_ = 0.f; \
        _Pragma("unroll") for (int e = 0; e < 16; ++e) { Scur[e] = __builtin_amdgcn_exp2f(Scur[e]); ps_ += Scur[e]; } \
        lsum += ps_; \
        u32x4 p0_, p1_; \
        p0_.x = pk2(Scur[0], Scur[1]); p0_.y = pk2(Scur[2], Scur[3]); p0_.z = pk2(Scur[4], Scur[5]); p0_.w = pk2(Scur[6], Scur[7]); \
        p1_.x = pk2(Scur[8], Scur[9]); p1_.y = pk2(Scur[10], Scur[11]); p1_.z = pk2(Scur[12], Scur[13]); p1_.w = pk2(Scur[14], Scur[15]); \
        const bf16x8 pb0_ = __builtin_bit_cast(bf16x8, p0_), pb1_ = __builtin_bit_cast(bf16x8, p1_); \
        __builtin_amdgcn_sched_barrier(0); \
        { LAS unsigned char* vb_ = lds + (vsl) * 32768 + 16384 + r * 128; \
          _Pragma("unroll") for (int dvt = 2; dvt < 4; ++dvt) _Pragma("unroll") for (int s2 = 0; s2 < 2; ++s2) vf_[2 * dvt + s2] = *(const LAS bf16x8*)(vb_ + dvt * 4096 + (((4 * (vkt) + 2 * s2 + hh) ^ sw) << 4)); } \
        if (DOQK) { Snxt = __builtin_amdgcn_mfma_f32_32x32x16_bf16(kf_[0], qf[0], negm, 0, 0, 0); \
            _Pragma("unroll") for (int s_ = 1; s_ < 4; ++s_) Snxt = __builtin_amdgcn_mfma_f32_32x32x16_bf16(kf_[s_], qf[s_], Snxt, 0, 0, 0); } \
        _Pragma("unroll") for (int dvt = 0; dvt < 4; ++dvt) { \
            o[dvt] = __builtin_amdgcn_mfma_f32_32x32x16_bf16(vf_[2 * dvt], pb0_, o[dvt], 0, 0, 0); \
            o[dvt] = __builtin_amdgcn_mfma_f32_32x32x16_bf16(vf_[2 * dvt + 1], pb1_, o[dvt], 0, 0, 0); } \
        __builtin_amdgcn_sched_barrier(0); } while (0)
    f32x16 Sa, Sb;
    { LAS unsigned char* kb_ = lds + comp * 8192 + r * 128;
      Sa = __builtin_amdgcn_mfma_f32_32x32x16_bf16(*(const LAS bf16x8*)(kb_ + (((0 + hh) ^ sw) << 4)), qf[0], negm, 0, 0, 0);
      Sa = __builtin_amdgcn_mfma_f32_32x32x16_bf16(*(const LAS bf16x8*)(kb_ + (((2 + hh) ^ sw) << 4)), qf[1], Sa, 0, 0, 0);
      Sa = __builtin_amdgcn_mfma_f32_32x32x16_bf16(*(const LAS bf16x8*)(kb_ + (((4 + hh) ^ sw) << 4)), qf[2], Sa, 0, 0, 0);
      Sa = __builtin_amdgcn_mfma_f32_32x32x16_bf16(*(const LAS bf16x8*)(kb_ + (((6 + hh) ^ sw) << 4)), qf[3], Sa, 0, 0, 0); }
#define AT_STEPB(Scur, Snxt, ksl, kkt, vsl, vkt, DOQK, DOPV) do { \
        bf16x8 kf_[4], vf_[8]; \
        { LAS unsigned char* kb_ = lds + (ksl) * 32768 + comp * 8192 + r * 128 + (kkt) * 4096; \
          LAS unsigned char* vb_ = lds + (vsl) * 32768 + 16384 + r * 128; \
          if (DOQK) { _Pragma("unroll") for (int s_ = 0; s_ < 4; ++s_) kf_[s_] = *(const LAS bf16x8*)(kb_ + (((2 * s_ + hh) ^ sw) << 4)); } \
          if (DOPV) { _Pragma("unroll") for (int dvt = 0; dvt < 2; ++dvt) _Pragma("unroll") for (int s2 = 0; s2 < 2; ++s2) vf_[2 * dvt + s2] = *(const LAS bf16x8*)(vb_ + dvt * 4096 + (((4 * (vkt) + 2 * s2 + hh) ^ sw) << 4)); } } \
        __builtin_amdgcn_sched_barrier(0); \
        if (DOPV) { LAS unsigned char* vb_ = lds + (vsl) * 32768 + 16384 + r * 128; \
          _Pragma("unroll") for (int dvt = 2; dvt < 4; ++dvt) _Pragma("unroll") for (int s2 = 0; s2 < 2; ++s2) vf_[2 * dvt + s2] = *(const LAS bf16x8*)(vb_ + dvt * 4096 + (((4 * (vkt) + 2 * s2 + hh) ^ sw) << 4)); } \
        if (DOQK) { Snxt = __builtin_amdgcn_mfma_f32_32x32x16_bf16(kf_[0], qf[0], negm, 0, 0, 0); \
            _Pragma("unroll") for (int s_ = 1; s_ < 4; ++s_) Snxt = __builtin_amdgcn_mfma_f32_32x32x16_bf16(kf_[s_], qf[s_], Snxt, 0, 0, 0); } \
        if (DOPV) { _Pragma("unroll") for (int dvt = 0; dvt < 4; ++dvt) { \
            o[dvt] = __builtin_amdgcn_mfma_f32_32x32x16_bf16(vf_[2 * dvt], Pp0, o[dvt], 0, 0, 0); \
            o[dvt] = __builtin_amdgcn_mfma_f32_32x32x16_bf16(vf_[2 * dvt + 1], Pp1, o[dvt], 0, 0, 0); } } \
        __builtin_amdgcn_sched_barrier(0); \
        { float ps_ = 0.f; \
        _Pragma("unroll") for (int e = 0; e < 16; ++e) { Scur[e] = __builtin_amdgcn_exp2f(Scur[e]); ps_ += Scur[e]; } \
        lsum += ps_; \
        u32x4 p0_, p1_; \
        p0_.x = pk2(Scur[0], Scur[1]); p0_.y = pk2(Scur[2], Scur[3]); p0_.z = pk2(Scur[4], Scur[5]); p0_.w = pk2(Scur[6], Scur[7]); \
        p1_.x = pk2(Scur[8], Scur[9]); p1_.y = pk2(Scur[10], Scur[11]); p1_.z = pk2(Scur[12], Scur[13]); p1_.w = pk2(Scur[14], Scur[15]); \
        Pp0 = __builtin_bit_cast(bf16x8, p0_); Pp1 = __builtin_bit_cast(bf16x8, p1_); } \
        __builtin_amdgcn_sched_barrier(0); } while (0)
    int slot = 0;
    if (comp == 0) {
        for (int t = 0; t < ntiles; ++t) {
            const int slot1 = slot == 2 ? 0 : slot + 1, slot2 = slot1 == 2 ? 0 : slot1 + 1;
            AT_STEP(Sa, Sb, slot, 1, slot, 0, true);
            asm volatile("s_waitcnt vmcnt(0)" ::: "memory");
            __syncthreads();
            if (t + 2 < ntiles) AT_DMA(t + 2, slot2);
            if (t + 1 < ntiles) AT_STEP(Sb, Sa, slot1, 0, slot, 1, true); else AT_STEP(Sb, Sa, slot1, 0, slot, 1, false);
            slot = slot1;
        }
    } else {
        int lane_b = lane; asm volatile("" : "+v"(lane_b));
        const int r = lane_b & 31, hh = lane_b >> 5, sw = (r >> 1) & 7;
        bf16x8 Pp0 = {}, Pp1 = {};
        int slotp = 0;
        for (int t = 0; t < ntiles; ++t) {
            const int slot1 = slot == 2 ? 0 : slot + 1, slot2 = slot1 == 2 ? 0 : slot1 + 1;
            if (t > 0) AT_STEPB(Sa, Sb, slot, 1, slotp, 1, true, true); else AT_STEPB(Sa, Sb, slot, 1, slotp, 1, true, false);
            asm volatile("s_waitcnt vmcnt(0)" ::: "memory");
            __syncthreads();
            if (t + 2 < ntiles) AT_DMA(t + 2, slot2);
            if (t + 1 < ntiles) AT_STEPB(Sb, Sa, slot1, 0, slot, 0, true, true); else AT_STEPB(Sb, Sa, slot1, 0, slot, 0, false, true);
            slotp = slot; slot = slot1;
        }
        { LAS unsigned char* vb_ = lds + slotp * 32768 + 16384 + r * 128;
#pragma unroll
          for (int dvt = 0; dvt < 4; ++dvt) {
              o[dvt] = __builtin_amdgcn_mfma_f32_32x32x16_bf16(*(const LAS bf16x8*)(vb_ + dvt * 4096 + (((4 + hh) ^ sw) << 4)), Pp0, o[dvt], 0, 0, 0);
              o[dvt] = __builtin_amdgcn_mfma_f32_32x32x16_bf16(*(const LAS bf16x8*)(vb_ + dvt * 4096 + (((6 + hh) ^ sw) << 4)), Pp1, o[dvt], 0, 0, 0); } }
    }
    __syncthreads();
#undef AT_STEP
#undef AT_STEPB
#undef AT_KROW
#undef AT_DMA
    lsum += shx(lsum, lane, 32);
    const float inv = 1.f / lsum;
    LAS float* X = (LAS float*)lds;
    if (comp == 1) { const float sc = lam * inv;
#pragma unroll
        for (int dvt = 0; dvt < 4; ++dvt)
#pragma unroll
            for (int e = 0; e < 16; ++e) X[((qt * 4 + dvt) * 16 + e) * 64 + lane] = o[dvt][e] * sc; }
    __syncthreads();
    if (comp == 0) {
        float ss = 0.f;
#pragma unroll
        for (int dvt = 0; dvt < 4; ++dvt)
#pragma unroll
            for (int e = 0; e < 16; ++e) { const float v = o[dvt][e] * inv - X[((qt * 4 + dvt) * 16 + e) * 64 + lane]; o[dvt][e] = v; ss += v * v; }
        ss += shx(ss, lane, 32);
        const float rstd = __builtin_amdgcn_rsqf(ss * (1.f / 128.f) + EPS) * oscale;
        LAS unsigned char* stg = lds + 65536 + qt * (32 * 272);
#pragma unroll
        for (int dvt = 0; dvt < 4; ++dvt)
#pragma unroll
            for (int g = 0; g < 4; ++g) { const int dv0 = 32 * dvt + 8 * g + 4 * hh; const f32x4 gg = *(const f32x4*)(sg + dv0);
                u32x2 wv; wv.x = pk2(o[dvt][4 * g] * rstd * gg[0], o[dvt][4 * g + 1] * rstd * gg[1]); wv.y = pk2(o[dvt][4 * g + 2] * rstd * gg[2], o[dvt][4 * g + 3] * rstd * gg[3]);
                *(LAS u32x2*)(stg + r * 272 + dv0 * 2) = wv; }
        asm volatile("s_waitcnt lgkmcnt(0)" ::: "memory");
#pragma unroll
        for (int i = 0; i < 8; ++i) { const int id = lane + 64 * i, row = id >> 4, c = id & 15;
            const u32x4 v = *(const LAS u32x4*)(stg + row * 272 + c * 16);
            *(u32x4*)(MIX + (size_t)(qrow0 + 32 * qt + row) * DM + 512 + h * 128 + c * 8) = v; }
    }
    __syncthreads();
}

__device__ __forceinline__ void conv3x4(const bf16_t* row, int t0, int lo, int hi, float w0, float w1, float w2, float bb, float (&y)[4]) {
    const u32x2 v = *(const u32x2*)(row + t0);
    float p[6]; p[1] = bf_lo(v.x); p[2] = bf_hi(v.x); p[3] = bf_lo(v.y); p[4] = bf_hi(v.y);
    p[0] = (t0 - 1 >= lo) ? bf2f(row[t0 - 1]) : 0.f; p[5] = (t0 + 4 < hi) ? bf2f(row[t0 + 4]) : 0.f;
#pragma unroll
    for (int j = 0; j < 4; ++j) y[j] = w0 * p[j] + w1 * p[j + 1] + w2 * p[j + 2] + bb;
}
__device__ __forceinline__ float conv3x1(const bf16_t* row, int t, int lo, int hi, float w0, float w1, float w2, float bb) {
    const float a = (t - 1 >= lo) ? bf2f(row[t - 1]) : 0.f, b = bf2f(row[t]), c = (t + 1 < hi) ? bf2f(row[t + 1]) : 0.f;
    return w0 * a + w1 * b + w2 * c + bb;
}
typedef _Float16 h16x2 __attribute__((ext_vector_type(2)));
constexpr int FN = 16384;
__device__ __forceinline__ int fpad(int i) { return i + (i >> 4); }
__device__ __forceinline__ f32x2 cmul(f32x2 a, f32x2 w) { return (f32x2){a.x * w.x - a.y * w.y, a.x * w.y + a.y * w.x}; }
template <bool INV> __device__ __forceinline__ void fft4(f32x2& a, f32x2& b, f32x2& c, f32x2& d) {
    const f32x2 s0 = a + c, s1 = a - c, s2 = b + d, s3 = b - d;
    const f32x2 r3 = INV ? (f32x2){-s3.y, s3.x} : (f32x2){s3.y, -s3.x};
    a = s0 + s2; c = s0 - s2; b = s1 + r3; d = s1 - r3;
}
template <bool INV> __device__ __forceinline__ void fft16(f32x2 (&v)[16]) {
#pragma unroll
    for (int n1 = 0; n1 < 4; ++n1) fft4<INV>(v[n1], v[n1 + 4], v[n1 + 8], v[n1 + 12]);
    constexpr float C1 = 0.92387953251128674f, S1 = 0.38268343236508977f, C2 = 0.70710678118654752f;
    constexpr float sg = INV ? 1.f : -1.f;
    v[5] = cmul(v[5], (f32x2){C1, sg * S1}); v[9] = cmul(v[9], (f32x2){C2, sg * C2}); v[13] = cmul(v[13], (f32x2){S1, sg * C1});
    v[6] = cmul(v[6], (f32x2){C2, sg * C2}); v[10] = cmul(v[10], (f32x2){0.f, sg}); v[14] = cmul(v[14], (f32x2){-C2, sg * C2});
    v[7] = cmul(v[7], (f32x2){S1, sg * C1}); v[11] = cmul(v[11], (f32x2){-C2, sg * C2}); v[15] = cmul(v[15], (f32x2){-C1, -sg * S1});
#pragma unroll
    for (int k2 = 0; k2 < 4; ++k2) fft4<INV>(v[4 * k2], v[4 * k2 + 1], v[4 * k2 + 2], v[4 * k2 + 3]);
}
template <bool INV, int P, class LF>
__device__ __forceinline__ void fft_pass16(LAS f32x2* X, int tid, LF load) {
    asm volatile("" : "+v"(tid));
    f32x2 v[2][16];
#pragma unroll
    for (int bi = 0; bi < 2; ++bi) { const int t = tid + 512 * bi;
#pragma unroll
        for (int r = 0; r < 16; ++r) v[bi][r] = load(t, r); }
#pragma unroll
    for (int bi = 0; bi < 2; ++bi) { const int t = tid + 512 * bi;
        if (P > 1) { const int k = t & (P - 1); const float rv_ = (float)k * (1.f / (float)(P * 16)); const float sn = __builtin_amdgcn_sinf(rv_), cs = __builtin_amdgcn_cosf(rv_);
            const f32x2 w1 = {cs, INV ? sn : -sn}; f32x2 w = w1;
#pragma unroll
            for (int r = 1; r < 16; ++r) { v[bi][r] = cmul(v[bi][r], w); if (r < 15) w = cmul(w, w1); } }
        fft16<INV>(v[bi]); }
    __syncthreads();
#pragma unroll
    for (int bi = 0; bi < 2; ++bi) { const int t = tid + 512 * bi; const int k = t & (P - 1); const int j0 = (t - k) * 16 + k;
#pragma unroll
        for (int m = 0; m < 16; ++m) X[fpad(j0 + m * P)] = v[bi][4 * (m & 3) + (m >> 2)]; }
    __syncthreads();
}
template <bool INV, bool TOREG>
__device__ __forceinline__ void fft_pass4(LAS f32x2* X, int tid, f32x2 (&out)[8][2]) {
    asm volatile("" : "+v"(tid));
    f32x2 v[8][4];
#pragma unroll
    for (int i = 0; i < 8; ++i) { const int t = tid + 512 * i;
#pragma unroll
        for (int r = 0; r < 4; ++r) v[i][r] = X[fpad(t + 4096 * r)]; }
#pragma unroll
    for (int i = 0; i < 8; ++i) { const int t = tid + 512 * i; const float rv_ = (float)t * (1.f / 16384.f); const float sn = __builtin_amdgcn_sinf(rv_), cs = __builtin_amdgcn_cosf(rv_);
        const f32x2 w1 = {cs, INV ? sn : -sn}; const f32x2 w2 = cmul(w1, w1), w3 = cmul(w2, w1);
        v[i][1] = cmul(v[i][1], w1); v[i][2] = cmul(v[i][2], w2); v[i][3] = cmul(v[i][3], w3);
        fft4<INV>(v[i][0], v[i][1], v[i][2], v[i][3]); }
    __syncthreads();
    if (TOREG) {
#pragma unroll
        for (int i = 0; i < 8; ++i) { out[i][0] = v[i][0]; out[i][1] = v[i][1]; }
    } else {
#pragma unroll
        for (int i = 0; i < 8; ++i) { const int t = tid + 512 * i;
#pragma unroll
            for (int r = 0; r < 4; ++r) X[fpad(t + 4096 * r)] = v[i][r]; }
        __syncthreads();
    }
}
__device__ __forceinline__ f32x2 kf_load(const unsigned* F, int f) {
    const int g = f <= 8192 ? f : FN - f;
    const h16x2 hv = __builtin_bit_cast(h16x2, F[g & 8191]);
    float re = (float)hv.x, im = (float)hv.y;
    if (g == 0) im = 0.f; else if (g == 8192) { re = im; im = 0.f; } else if (f > 8192) im = -im;
    return (f32x2){re, im};
}
__device__ __forceinline__ void filter_fft_unit(LAS f32x2* X, const float* TD0, const float* TD1, unsigned* F0, unsigned* F1) {
    int tid = threadIdx.x; asm volatile("" : "+v"(tid));
    fft_pass16<false, 1>(X, tid, [&](int t, int r) -> f32x2 { const int idx = t + 1024 * r; return (f32x2){TD0[idx], TD1[idx]}; });
    auto ldl = [&](int t, int r) -> f32x2 { return X[fpad(t + 1024 * r)]; };
    fft_pass16<false, 16>(X, tid, ldl); fft_pass16<false, 256>(X, tid, ldl);
    f32x2 dummy[8][2]; fft_pass4<false, false>(X, tid, dummy);
    for (int i = 0; i < 16; ++i) { const int f = tid + 512 * i;
        const f32x2 zf = X[fpad(f)], zn = X[fpad((FN - f) & (FN - 1))];
        h16x2 k0 = {(_Float16)(0.5f * (zf.x + zn.x)), (_Float16)(0.5f * (zf.y - zn.y))}, k1 = {(_Float16)(0.5f * (zf.y + zn.y)), (_Float16)(0.5f * (zn.x - zf.x))};
        if (f == 0) { const f32x2 zh = X[fpad(8192)]; k0 = (h16x2){(_Float16)zf.x, (_Float16)zh.x}; k1 = (h16x2){(_Float16)zf.y, (_Float16)zh.y}; }
        F0[f] = __builtin_bit_cast(unsigned, k0); F1[f] = __builtin_bit_cast(unsigned, k1); }
    __syncthreads();
}
__device__ __forceinline__ void hyena_unit(LAS unsigned char* lds, int layer, int c, const bf16_t* PHt, const unsigned* FH, const float* FILTC, const float* cw, const float* cb, const float* hbias, bf16_t* MIX, bool do_ctx) {
    int tid = threadIdx.x; asm volatile("" : "+v"(tid));
    LAS f32x2* X = (LAS f32x2*)lds;
    const bf16_t* x1row = PHt + (size_t)c * MROWS; const bf16_t* x2row = PHt + (size_t)(256 + c) * MROWS; const bf16_t* vrow = PHt + (size_t)(512 + c) * MROWS;
    const float w10 = cw[c], w11 = cw[768 + c], w12 = cw[1536 + c], bb1 = cb[c];
    const float w20 = cw[256 + c], w21 = cw[768 + 256 + c], w22 = cw[1536 + 256 + c], bb2 = cb[256 + c];
    const float wv0 = cw[512 + c], wv1 = cw[768 + 512 + c], wv2 = cw[1536 + 512 + c], bbv = cb[512 + c];
    const float bias0 = hbias[c], bias1 = hbias[256 + c];
    const unsigned* F0 = FH + ((size_t)(layer * 256 + c) * 2) * 8192; const unsigned* F1 = F0 + 8192;
    auto ldl = [&](int t, int r) -> f32x2 { return X[fpad(t + 1024 * r)]; };
    auto ldz = [&](int t, int r) -> f32x2 { if (r >= 8) return (f32x2){0.f, 0.f}; return X[fpad(t + 1024 * r)]; };
    const float sc = 1.f / 16384.f;
    f32x2 y[8][2], z[8][2];
    __syncthreads();
#pragma unroll 4
    for (int i = 0; i < 16; ++i) { const int t = tid + 512 * i;
        X[fpad(t)] = (f32x2){conv3x1(vrow, t, 0, SEQ, wv0, wv1, wv2, bbv), conv3x1(vrow, SEQ + t, SEQ, 2 * SEQ, wv0, wv1, wv2, bbv)}; }
    __syncthreads();
    fft_pass16<false, 1>(X, tid, ldz);
    fft_pass16<false, 16>(X, tid, ldl); fft_pass16<false, 256>(X, tid, ldl); fft_pass4<false, false>(X, tid, y);
#pragma unroll 8
    for (int i = 0; i < 32; ++i) { const int f = tid + 512 * i; X[fpad(f)] = cmul(X[fpad(f)], kf_load(F0, f)) * sc; }
    __syncthreads();
    fft_pass16<true, 1>(X, tid, ldl);
    fft_pass16<true, 16>(X, tid, ldl); fft_pass16<true, 256>(X, tid, ldl); fft_pass4<true, true>(X, tid, y);
#pragma unroll
    for (int i = 0; i < 8; ++i)
#pragma unroll
        for (int r = 0; r < 2; ++r) { const int t = tid + 512 * i + 4096 * r;
            const f32x2 vv = {conv3x1(vrow, t, 0, SEQ, wv0, wv1, wv2, bbv), conv3x1(vrow, SEQ + t, SEQ, 2 * SEQ, wv0, wv1, wv2, bbv)};
            const f32x2 x1 = {conv3x1(x1row, t, 0, SEQ, w10, w11, w12, bb1), conv3x1(x1row, SEQ + t, SEQ, 2 * SEQ, w10, w11, w12, bb1)};
            z[i][r] = x1 * (y[i][r] + vv * bias0); X[fpad(t)] = z[i][r]; if (r) asm volatile("" ::: "memory"); }
    __syncthreads();
    fft_pass16<false, 1>(X, tid, ldz);
    fft_pass16<false, 16>(X, tid, ldl); fft_pass16<false, 256>(X, tid, ldl); fft_pass4<false, false>(X, tid, y);
#pragma unroll 8
    for (int i = 0; i < 32; ++i) { const int f = tid + 512 * i; X[fpad(f)] = cmul(X[fpad(f)], kf_load(F1, f)) * sc; }
    __syncthreads();
    fft_pass16<true, 1>(X, tid, ldl);
    fft_pass16<true, 16>(X, tid, ldl); fft_pass16<true, 256>(X, tid, ldl); fft_pass4<true, true>(X, tid, y);
#pragma unroll
    for (int i = 0; i < 8; ++i)
#pragma unroll
        for (int r = 0; r < 2; ++r) { const int t = tid + 512 * i + 4096 * r;
            const f32x2 x2 = {conv3x1(x2row, t, 0, SEQ, w20, w21, w22, bb2), conv3x1(x2row, SEQ + t, SEQ, 2 * SEQ, w20, w21, w22, bb2)};
            const f32x2 o = x2 * (y[i][r] + z[i][r] * bias1);
            MIX[(size_t)t * DM + c] = f2bf(o.x); MIX[(size_t)(SEQ + t) * DM + c] = f2bf(o.y); if ((i & 1) && r) asm volatile("" ::: "memory"); }
    __syncthreads();
    if (do_ctx) {
        LAS float* G = (LAS float*)lds;
        LAS float* U = (LAS float*)(lds + 4096);
        LAS float* Z = (LAS float*)(lds + 6144);
        const float* gc = FILTC + (size_t)c * 1024;
        G[tid] = gc[tid]; G[512 + tid] = gc[512 + tid];
        const int bc = tid >> 8, t = tid & 255; const int lo = MLAT + bc * CTXL, hi = lo + CTXL; const int tk = lo + t;
        const float vv = conv3x1(vrow, tk, lo, hi, wv0, wv1, wv2, bbv);
        U[tid] = vv;
        __syncthreads();
        float a = 0.f;
        for (int s = 0; s < 256; ++s) a += G[256 + t - s] * U[bc * 256 + s];
        const float zz = conv3x1(x1row, tk, lo, hi, w10, w11, w12, bb1) * (a + bias0 * vv);
        Z[tid] = zz;
        __syncthreads();
        float a2 = 0.f;
        for (int s = 0; s < 256; ++s) a2 += G[512 + 256 + t - s] * Z[bc * 256 + s];
        MIX[(size_t)tk * DM + c] = f2bf(conv3x1(x2row, tk, lo, hi, w20, w21, w22, bb2) * (a2 + bias1 * zz));
        __syncthreads();
    }
}

__device__ __forceinline__ void sgu_unit(LAS unsigned char* lds, int ch, const bf16_t* SG, const float* ng, const float* ws, const float* bs, bf16_t* MIX) {
    int tid = threadIdx.x; asm volatile("" : "+v"(tid));
    const int lane = tid & 63, w = __builtin_amdgcn_readfirstlane(tid >> 6), r = lane & 31, hh = lane >> 5;
    const int m0 = ch * 128;
    const f32x4 g4 = *(const f32x4*)(ng + 4 * lane);
    for (int q = 16 * w; q < 16 * w + 16; ++q) {
        const u32x2 v = *(const u32x2*)(SG + (size_t)(m0 + q) * 512 + 256 + 4 * lane);
        const float a = bf_lo(v.x), b = bf_hi(v.x), c = bf_lo(v.y), d = bf_hi(v.y);
        const float rstd = __builtin_amdgcn_rsqf(wave_sum(a * a + b * b + c * c + d * d, lane) * (1.f / 256.f) + EPS);
        LAS bf16_t* vt = (LAS bf16_t*)lds + (4 * lane) * 136 + q;
        vt[0] = f2bf(a * rstd * g4[0]); vt[136] = f2bf(b * rstd * g4[1]); vt[272] = f2bf(c * rstd * g4[2]); vt[408] = f2bf(d * rstd * g4[3]);
    }
    __syncthreads();
    const int head = w >> 1, ctile = w & 1;
    f32x16 acc[4];
#pragma unroll
    for (int i = 0; i < 4; ++i) acc[i] = (f32x16){};
    for (int ks = 0; ks < 8; ++ks) {
        const bf16x8 bfr = *(const LAS bf16x8*)(lds + (size_t)((64 * head + 32 * ctile + r) * 136 + 16 * ks + 8 * hh) * 2);
#pragma unroll
        for (int rt = 0; rt < 4; ++rt) { const float* wp = ws + ((size_t)head * 128 + 32 * rt + r) * 128 + 16 * ks + 8 * hh;
            const f32x4 a0 = *(const f32x4*)wp, a1 = *(const f32x4*)(wp + 4);
            u32x4 aw; aw.x = pk2(a0[0], a0[1]); aw.y = pk2(a0[2], a0[3]); aw.z = pk2(a1[0], a1[1]); aw.w = pk2(a1[2], a1[3]);
            acc[rt] = __builtin_amdgcn_mfma_f32_32x32x16_bf16(__builtin_bit_cast(bf16x8, aw), bfr, acc[rt], 0, 0, 0); }
    }
    const int d = 64 * head + 32 * ctile + r;
#pragma unroll
    for (int rt = 0; rt < 4; ++rt)
#pragma unroll
        for (int e = 0; e < 16; ++e) { const int p = 32 * rt + (e & 3) + 8 * (e >> 2) + 4 * hh;
            const float mixed = acc[rt][e] + bs[head * 128 + p];
            const float u = bf2f(SG[(size_t)(m0 + p) * 512 + d]);
            MIX[(size_t)(m0 + p) * DM + 256 + d] = f2bf(u * mixed); }
    __syncthreads();
}

template <class EpiF>
__device__ __forceinline__ void ctx_gemm(LAS unsigned char* lds, const bf16_t* A, const bf16_t* Bt, const int K, const int vcu, const int G, EpiF epi) {
    int tid = threadIdx.x; asm volatile("" : "+v"(tid));
    const int lane = tid & 63, w = __builtin_amdgcn_readfirstlane(tid >> 6), r = lane & 31, hh = lane >> 5;
    const int kper = K >> 3;
    for (int tile = vcu; tile < 256; tile += G) {
        const int m0 = (tile >> 5) * 64, n0 = (tile & 31) * 32;
        const bf16_t* ap = A + (size_t)(m0 + r) * K + w * kper + 8 * hh;
        const bf16_t* bp = Bt + (size_t)(n0 + r) * K + w * kper + 8 * hh;
        f32x16 acc0 = {}, acc1 = {};
#pragma unroll 2
        for (int k = 0; k < kper; k += 16) {
            const bf16x8 a0 = *(const bf16x8*)(ap + k), a1 = *(const bf16x8*)(ap + (size_t)32 * K + k), b = *(const bf16x8*)(bp + k);
            acc0 = __builtin_amdgcn_mfma_f32_32x32x16_bf16(a0, b, acc0, 0, 0, 0);
            acc1 = __builtin_amdgcn_mfma_f32_32x32x16_bf16(a1, b, acc1, 0, 0, 0);
        }
        LAS float* Pw = (LAS float*)lds + w * 2048;
#pragma unroll
        for (int e = 0; e < 16; ++e) { Pw[e * 64 + lane] = acc0[e]; Pw[1024 + e * 64 + lane] = acc1[e]; }
        __syncthreads();
#pragma unroll
        for (int i = 0; i < 4; ++i) { const int idx = tid + 512 * i; float sv = 0.f;
#pragma unroll
            for (int ww = 0; ww < 8; ++ww) sv += ((LAS float*)lds)[ww * 2048 + idx];
            const int half = idx >> 10, e = (idx >> 6) & 15, ln = idx & 63;
            epi(m0 + 32 * half + (e & 3) + 8 * (e >> 2) + 4 * (ln >> 5), n0 + (ln & 31), sv); }
        __syncthreads();
    }
}

#define XB_TMO      128
#define XB_XCNT(j)  (256  + 64 * (j))
#define XB_XSUB(j)  (1280 + 64 * (j))
#define XB_XGEN(j)  (2304 + 64 * (j))
#define XB_TOP      3328
#define XB_TOPGEN   3392
#define XCD_BAR_WORDS 3456
#define XB_SPIN_CAP (1u << 18)
__device__ __forceinline__ unsigned xb_ld(unsigned* p)              { return __hip_atomic_load(p, __ATOMIC_RELAXED, __HIP_MEMORY_SCOPE_AGENT); }
__device__ __forceinline__ unsigned xb_add(unsigned* p, unsigned v) { return __hip_atomic_fetch_add(p, v, __ATOMIC_RELAXED, __HIP_MEMORY_SCOPE_AGENT); }
__device__ __forceinline__ unsigned xb_xcc_id() { return (unsigned)__builtin_amdgcn_s_getreg((3 << 11) | 20) & 0xFu; }
#define XB_SPIN(cond, bar) do { unsigned _sp = 0; while (cond) { __builtin_amdgcn_s_sleep(1); \
    if ((++_sp & 255u) == 0u) { if (xb_ld(&(bar)[XB_TMO])) break; if (_sp > XB_SPIN_CAP) { atomicAdd(&(bar)[XB_TMO], 1u); break; } } } } while (0)
struct XcdBarrier { unsigned* bar; unsigned x; volatile LAS unsigned* st; };
__device__ __forceinline__ XcdBarrier xcd_barrier_post(unsigned* bar, volatile LAS unsigned* st) {
    XcdBarrier b; b.bar = bar; b.x = xb_xcc_id(); b.st = st;
    if (threadIdx.x == 0) (void)xb_add(&bar[XB_XCNT(b.x)], 1u);
    return b;
}
__device__ __forceinline__ void xcd_barrier_complete(unsigned* bar, unsigned x, unsigned& nloc, unsigned& nx) {
    const unsigned G = gridDim.x * gridDim.y * gridDim.z;
    unsigned sum, cnt, mine, sp = 0u;
    for (;;) {
        sum = 0u; cnt = 0u; mine = 0u;
#pragma unroll
        for (unsigned j = 0; j < 16; ++j) { const unsigned c = xb_ld(&bar[XB_XCNT(j)]); sum += c; cnt += (c > 0u) ? 1u : 0u; mine = (j == x) ? c : mine; }
        if (sum == G) break;
        __builtin_amdgcn_s_sleep(1);
        if ((++sp & 255u) == 0u) { if (xb_ld(&bar[XB_TMO])) break; if (sp > XB_SPIN_CAP) { atomicAdd(&bar[XB_TMO], 1u); break; } }
    }
    nloc = mine > 0u ? mine : 1u; nx = cnt > 0u ? cnt : 1u;
}
__device__ __forceinline__ void xcd_barrier(const XcdBarrier& b) {
    asm volatile("s_waitcnt vmcnt(0)" ::: "memory");
    __syncthreads();
    if (threadIdx.x == 0) {
        unsigned* bar = b.bar;
        __builtin_amdgcn_s_waitcnt(0);
        unsigned nloc = b.st[0], nx = b.st[1];
        if (nloc == 0u) { xcd_barrier_complete(bar, b.x, nloc, nx); b.st[0] = nloc; b.st[1] = nx; }
        const unsigned old = xb_add(&bar[XB_XSUB(b.x)], 1u);
        const unsigned gen = old / nloc;
        if (old + 1u == (gen + 1u) * nloc) {
            __builtin_amdgcn_fence(__ATOMIC_RELEASE, "agent");
            asm volatile("s_waitcnt vmcnt(0)" ::: "memory");
            const unsigned og = xb_add(&bar[XB_TOP], 1u);
            const unsigned tg = og / nx;
            if (og + 1u == (tg + 1u) * nx) xb_add(&bar[XB_TOPGEN], 1u);
            else XB_SPIN(xb_ld(&bar[XB_TOPGEN]) == tg, bar);
            __builtin_amdgcn_fence(__ATOMIC_ACQUIRE, "agent");
            xb_add(&bar[XB_XGEN(b.x)], 1u);
            asm volatile("s_waitcnt vmcnt(0)" ::: "memory");
        } else {
            XB_SPIN(xb_ld(&bar[XB_XGEN(b.x)]) == gen, bar);
            __builtin_amdgcn_fence(__ATOMIC_ACQUIRE, "agent");
            asm volatile("s_waitcnt vmcnt(0)" ::: "memory");
        }
    }
    __syncthreads();
}

struct Params { const float* in[28]; float* out; unsigned char* ws; int ph_lo, ph_hi; };
enum { I_X = 0, I_C, I_CTX, I_CCTX, I_N1G, I_N2G, I_ADAW, I_ADAB, I_WIN, I_HCW, I_HCB, I_HW1, I_HB1, I_HW2, I_HB2, I_HW3, I_HFREQ, I_HBIAS, I_SGNG, I_SGW, I_SGB, I_QNG, I_KNG, I_LAMP, I_SUBG, I_WOUT, I_FW1, I_FW2 };
constexpr int NPHASE = 2 + 7 * DEPTH;
#ifndef PHMASK
#define PHMASK 0xFFFF
#endif
#define PM(b) if constexpr ((PHMASK >> (b)) & 1)
#ifndef PROBE_DUP
#define PROBE_DUP 0
#endif

__global__ void __launch_bounds__(NTHREADS, 2) fwd_kernel(Params P) {
    extern __shared__ __attribute__((aligned(16))) unsigned char lds_raw[];
    LAS unsigned char* lds = (LAS unsigned char*)lds_raw;
    cg::grid_group grid = cg::this_grid();
    const int G = gridDim.x, bx = blockIdx.x;
    const int vcu = (G % 8 == 0) ? (bx % 8) * (G / 8) + bx / 8 : bx;
    const int NGW = G * 8;
#define MOD ((float*)(KP->ws + WS_MOD))
#define ROPE ((float*)(KP->ws + WS_ROPE))
#define CONSTS ((float*)(KP->ws + WS_CONST))
#define WinT ((bf16_t*)(KP->ws + WS_WIN))
#define WoutT ((bf16_t*)(KP->ws + WS_WOUT))
#define W1T ((bf16_t*)(KP->ws + WS_W1))
#define W2T ((bf16_t*)(KP->ws + WS_W2))
#define FILT ((unsigned*)(KP->ws + WS_FILT))
#define TDF ((float*)(KP->ws + WS_P))
#define FILTC ((float*)(KP->ws + WS_FILTC))
#define XC ((float*)(KP->ws + WS_XC))
#define H ((bf16_t*)(KP->ws + WS_H))
#define MIX ((bf16_t*)(KP->ws + WS_MIX))
#define PHt ((bf16_t*)(KP->ws + WS_PHT))
#define SG ((bf16_t*)(KP->ws + WS_SG))
#define Qb ((bf16_t*)(KP->ws + WS_Q))
#define Kb ((bf16_t*)(KP->ws + WS_K))
#define VT ((bf16_t*)(KP->ws + WS_VT))
#define ACT ((bf16_t*)(KP->ws + WS_ACT))
    const int lo = P.ph_lo, hi = P.ph_hi;
    int ph = 0;
    if (threadIdx.x < 2) ((LAS unsigned*)(lds + LDS_BYTES - 64))[threadIdx.x] = 0u;
    __syncthreads();
    XcdBarrier xbar = xcd_barrier_post((unsigned*)(P.ws + WS_CTL), (volatile LAS unsigned*)(lds + LDS_BYTES - 64));
    if (hi < 0) grid.sync();
#define PH_BEGIN if (ph >= lo && ph < hi) { const __attribute__((address_space(4))) Params* KP = (const __attribute__((address_space(4))) Params*)__builtin_amdgcn_kernarg_segment_ptr(); asm volatile("" : "+s"(KP)); \
    int tid = threadIdx.x; asm volatile("" : "+v"(tid)); const int lane = tid & 63, wave = __builtin_amdgcn_readfirstlane(tid >> 6), gw = vcu * 8 + wave; (void)lane; (void)gw;
#define PH_END if (ph + 1 < hi) xcd_barrier(xbar); } ++ph;

    if (PROBE_DUP & 16) { for (int q_ = 0; q_ < 16; ++q_) xcd_barrier(xbar); }
    PH_BEGIN
    for (int rep_ = 0; rep_ < ((PROBE_DUP & 1) ? 2 : 1); ++rep_)
    {
        PM(0) {
        LAS float* scr = (LAS float*)(lds + wave * 16384);
        constexpr int I_IN = 16 * 88, I_OUT = 16 * 32, I_1 = 16 * 176, I_2 = 44 * 32, I_LAYER = I_IN + I_OUT + I_1 + I_2;
        for (int it = gw; it < 2 * I_LAYER; it += NGW) {
            const int ly = it / I_LAYER; int rr = it % I_LAYER;
            if (rr < I_IN) { transpose_item(KP->in[I_WIN] + (size_t)ly * DM * INW, DM, INW, WinT + (size_t)ly * INW * DM, 1, scr, rr, lane); continue; } rr -= I_IN;
            if (rr < I_OUT) { transpose_item(KP->in[I_WOUT] + (size_t)ly * DM * DM, DM, DM, WoutT + (size_t)ly * DM * DM, 0, scr, rr, lane); continue; } rr -= I_OUT;
            if (rr < I_1) { transpose_item(KP->in[I_FW1] + (size_t)ly * DM * 2 * FFH, DM, 2 * FFH, W1T + (size_t)ly * 2 * FFH * DM, 2, scr, rr, lane); continue; } rr -= I_1;
            transpose_item(KP->in[I_FW2] + (size_t)ly * FFH * DM, FFH, DM, W2T + (size_t)ly * DM * FFH, 0, scr, rr, lane);
        }
        }
        PM(1) for (int it = gw; it < 2 * 1024 + 32; it += NGW) {
            int ly, L, l0, q4;
            if (it < 2048) { ly = it >> 10; L = SEQ; l0 = ((it & 1023) >> 2) * 32; q4 = it & 3; } else { const int k = it - 2048; ly = 0; L = CTXL; l0 = (k >> 2) * 32; q4 = k & 3; }
            int ln = lane; asm volatile("" : "+v"(ln));
            filter_task(ly, L, l0, q4, KP->in[I_HW1] + ly * 33 * 64, KP->in[I_HB1] + ly * 64, KP->in[I_HW2] + ly * 4096, KP->in[I_HB2] + ly * 64, KP->in[I_HW3] + (size_t)ly * 65536, KP->in[I_HFREQ] + ly * 128, TDF, FILTC, ln);
        }
        PM(2) { const int gt = vcu * NTHREADS + tid;
          if (gt < 2048) { const int pos = gt >> 4, i = gt & 15; const float invf = powf(10000.f, -(float)i / 16.f); const float ang = (float)pos * invf; ROPE[2 * gt] = cosf(ang); ROPE[2 * gt + 1] = sinf(ang); }
          if (gt >= 4096 && gt < 4096 + DEPTH) { const int ly = gt - 4096; const float* lp = KP->in[I_LAMP] + ly * 256; float d0 = 0.f, d1 = 0.f;
              for (int k = 0; k < 64; ++k) { d0 += lp[k] * lp[64 + k]; d1 += lp[128 + k] * lp[192 + k]; }
              const float lam_init = 0.8f - 0.6f * expf(-0.3f * (float)ly);
              float mq = 0.f, mk = 0.f; for (int k = 0; k < 64; ++k) { mq = fmaxf(mq, fabsf(KP->in[I_QNG][ly * 64 + k])); mk = fmaxf(mk, fabsf(KP->in[I_KNG][ly * 64 + k])); }
              CONSTS[ly * 4 + 0] = expf(d0) - expf(d1) + lam_init; CONSTS[ly * 4 + 1] = 8.f * mq * mk * 1.4426950408889634f + 0.5f; CONSTS[ly * 4 + 2] = 1.f - lam_init; }
        }
        __syncthreads();
        PM(2) for (int un = vcu; un < 192; un += G) {
            const int ly = un / 96, n0 = (un % 96) * 64;
            LAS float* sv = (LAS float*)lds;
            LAS float* part = (LAS float*)(lds + 16384);
            for (int k = tid; k < 3072; k += NTHREADS) { const int v = k >> 10, kk = k & 1023; const float x = v < 2 ? KP->in[I_C][v * DM + kk] : KP->in[I_CCTX][kk]; sv[k] = silu_f(x); }
            __syncthreads();
            const int cl = tid & 15, kg = tid >> 4;
            f32x4 a0 = {0.f, 0.f, 0.f, 0.f}, a1 = a0, a2 = a0;
            const float* wp = KP->in[I_ADAW] + (size_t)ly * DM * 6144 + n0 + 4 * cl;
            for (int k = kg * 32; k < kg * 32 + 32; ++k) { const f32x4 w4 = *(const f32x4*)(wp + (size_t)k * 6144); a0 += w4 * sv[k]; a1 += w4 * sv[1024 + k]; a2 += w4 * sv[2048 + k]; }
            *(LAS f32x4*)(part + (kg * 3 + 0) * 64 + 4 * cl) = a0; *(LAS f32x4*)(part + (kg * 3 + 1) * 64 + 4 * cl) = a1; *(LAS f32x4*)(part + (kg * 3 + 2) * 64 + 4 * cl) = a2;
            __syncthreads();
            if (tid < 192) { const int v = tid >> 6, col = tid & 63; float s = KP->in[I_ADAB][ly * 6144 + n0 + col];
                for (int k = 0; k < 32; ++k) s += part[(k * 3 + v) * 64 + col];
                MOD[(ly * 3 + v) * 6144 + n0 + col] = s; }
            __syncthreads();
        }
    }
    PH_END

    PH_BEGIN
    for (int rep_ = 0; rep_ < ((PROBE_DUP & 8) ? 2 : 1); ++rep_)
    for (int un = vcu; un < 512; un += G) { const float* td = TDF + (size_t)un * 2 * 16384; unsigned* fo = FILT + (size_t)un * 2 * 8192;
        filter_fft_unit((LAS f32x2*)lds, td, td + 16384, fo, fo + 8192); }
    PH_END

#pragma nounroll
    for (int ly = 0; ly < DEPTH; ++ly) {
        const bool last = ly == DEPTH - 1;
#define modl (MOD + ly * 3 * 6144)
#define xsrcL (ly == 0 ? KP->in[I_X] : (const float*)KP->out)
#define xsrcC (ly == 0 ? KP->in[I_CTX] : (const float*)XC)
        const int MG = last ? MLAT : MROWS;
        PH_BEGIN
        PM(3) for (int m = gw; m < MROWS; m += NGW) { const bool lat = m < MLAT; const int mv = lat ? (m >> 13) : 2;
            norm_row(lat ? xsrcL + (size_t)m * DM : xsrcC + (size_t)(m - MLAT) * DM, KP->in[I_N1G] + ly * DM, modl + mv * 6144 + 1024, modl + mv * 6144, H + (size_t)m * DM, lane); }
        PH_END
        PH_BEGIN
        for (int rep_ = 0; rep_ < ((PROBE_DUP & 64) ? 2 : 1); ++rep_)
        PM(4) { pg8::SchedG1 S{H, WinT + (size_t)ly * INW * DM, G, bx};
          pg8::EpiG1 E{PHt, SG, Qb, Kb, VT, KP->in[I_QNG] + ly * 64, KP->in[I_KNG] + ly * 64, ROPE, 0.125f * 1.4426950408889634f};
          pg8::gemm_phase(lds, DM, S, E); }
        PH_END
        PH_BEGIN
        {
            const float lam = CONSTS[ly * 4 + 0], mshift = CONSTS[ly * 4 + 1], oscale = CONSTS[ly * 4 + 2];
            const float* sgp = KP->in[I_SUBG] + ly * 128;
            for (int rep_ = 0; rep_ < ((PROBE_DUP & 2) ? 2 : 1); ++rep_)
            PM(5) for (int u = vcu; u < 512; u += G) { const int bh = u >> 6, qb = u & 63, b = bh >> 2, h = bh & 3;
                attn_unit(lds, Qb, Kb, VT, MIX, h, b * SEQ + 128 * qb, MLAT + b * CTXL, b * SEQ, 132, lam, mshift, sgp, oscale); }
            PM(5) if (!last) for (int u = vcu; u < 16; u += G) { const int b = u >> 3, h = (u >> 1) & 3, qb = u & 1;
                attn_unit(lds, Qb, Kb, VT, MIX, h, MLAT + b * CTXL + 128 * qb, MLAT + b * CTXL, 0, 4, lam, mshift, sgp, oscale); }
            for (int rep_ = 0; rep_ < ((PROBE_DUP & 4) ? 2 : 1); ++rep_)
            PM(6) for (int c = vcu; c < 256; c += G)
                hyena_unit(lds, ly, c, PHt, FILT, FILTC, KP->in[I_HCW] + ly * 3 * 768, KP->in[I_HCB] + ly * 768, KP->in[I_HBIAS] + ly * 512, MIX, !last);
            const int nch = last ? MLAT / 128 : MROWS / 128;
            for (int rep_ = 0; rep_ < ((PROBE_DUP & 32) ? 2 : 1); ++rep_)
            PM(7) for (int ch = G - 1 - vcu; ch < nch; ch += G)
                sgu_unit(lds, ch, SG, KP->in[I_SGNG] + ly * 256, KP->in[I_SGW] + (size_t)ly * 4 * 128 * 128, KP->in[I_SGB] + ly * 512, MIX);
        }
        PH_END
        PH_BEGIN
        PM(8) { pg8::SchedPlain S{MIX, WoutT + (size_t)ly * DM * DM, MLAT / 256, 4, G, bx, DM};
          pg8::EpiRes E{xsrcL, xsrcC, KP->out, XC, modl + 2048};
          pg8::gemm_phase(lds, DM, S, E);
          if (!last) { const float* bs = xsrcC; float* oc = XC; const float* gt = modl + 2 * 6144 + 2048;
              ctx_gemm(lds, MIX + (size_t)MLAT * DM, WoutT + (size_t)ly * DM * DM, DM, vcu, G, [&](int row, int col, float v) { oc[(size_t)row * DM + col] = bs[(size_t)row * DM + col] + gt[col] * v; }); } }
        PH_END
        PH_BEGIN
        PM(9) for (int m = gw; m < MG; m += NGW) { const bool lat = m < MLAT; const int mv = lat ? (m >> 13) : 2;
            norm_row(lat ? KP->out + (size_t)m * DM : XC + (size_t)(m - MLAT) * DM, KP->in[I_N2G] + ly * DM, modl + mv * 6144 + 4096, modl + mv * 6144 + 3072, H + (size_t)m * DM, lane); }
        PH_END
        PH_BEGIN
        PM(10) { pg8::SchedPlain S{H, W1T + (size_t)ly * 2 * FFH * DM, MG / 256, 22, G, bx, DM};
          pg8::EpiSwiglu E{ACT};
          pg8::gemm_phase(lds, DM, S, E); }
        PH_END
        PH_BEGIN
        PM(11) { pg8::SchedPlain S{ACT, W2T + (size_t)ly * DM * FFH, MLAT / 256, 4, G, bx, FFH};
          pg8::EpiRes E{KP->out, XC, KP->out, XC, modl + 5120};
          pg8::gemm_phase(lds, FFH, S, E);
          if (!last) { float* oc = XC; const float* gt = modl + 2 * 6144 + 5120;
              ctx_gemm(lds, ACT + (size_t)MLAT * FFH, W2T + (size_t)ly * DM * FFH, FFH, vcu, G, [&](int row, int col, float v) { oc[(size_t)row * DM + col] += gt[col] * v; }); } }
        PH_END
    }
#undef PH_BEGIN
#undef PH_END
}

#ifndef MK_N_LAUNCHES
#define MK_N_LAUNCHES 1
#endif
extern "C" void kernel_launch(void* const* d_in, const int* in_sizes, int n_in, void* d_out, int out_size, void* d_ws, size_t ws_size, hipStream_t stream) {
    static int grid = 0;
    if (grid == 0) {
        if (n_in != 28 || out_size != MLAT * DM || ws_size < WS_END) { fprintf(stderr, "kernel_launch: unexpected shapes (n_in %d out %d ws %zu)\n", n_in, out_size, ws_size); grid = -1; return; }
        int dev = 0, cus = 0, per_cu = 0;
        (void)hipGetDevice(&dev); (void)hipDeviceGetAttribute(&cus, hipDeviceAttributeMultiprocessorCount, dev);
        if (hipFuncSetAttribute((const void*)fwd_kernel, hipFuncAttributeMaxDynamicSharedMemorySize, LDS_BYTES) != hipSuccess) { fprintf(stderr, "kernel_launch: hipFuncSetAttribute failed\n"); grid = -1; return; }
        if (hipOccupancyMaxActiveBlocksPerMultiprocessor(&per_cu, (const void*)fwd_kernel, NTHREADS, LDS_BYTES) != hipSuccess || per_cu < 1) { fprintf(stderr, "kernel_launch: occupancy query %d\n", per_cu); per_cu = 1; }
        (void)hipGetLastError();
        grid = cus * 1;
    }
    if (grid < 0) return;
    if (hipMemsetAsync((char*)d_ws + WS_CTL, 0, CTL_BYTES, stream) != hipSuccess) { fprintf(stderr, "kernel_launch: memset failed\n"); return; }
    Params p{};
    for (int i = 0; i < 28; ++i) p.in[i] = (const float*)d_in[i];
    p.out = (float*)d_out; p.ws = (unsigned char*)d_ws;
#if MK_N_LAUNCHES == 1
    p.ph_lo = 0; p.ph_hi = NPHASE;
    void* args[] = {&p};
    hipError_t e = hipLaunchCooperativeKernel((const void*)fwd_kernel, dim3(grid), dim3(NTHREADS), args, LDS_BYTES, stream);
    if (e != hipSuccess) fprintf(stderr, "cooperative launch failed: %s (grid %d)\n", hipGetErrorString(e), grid);
#else
    for (int k = 0; k < NPHASE; ++k) { p.ph_lo = k; p.ph_hi = k + 1; hipLaunchKernelGGL(fwd_kernel, dim3(grid), dim3(NTHREADS), LDS_BYTES, stream, p); }
#endif
}
```
